# Optimizing an MI355X kernel written in HIP

```python
import math
import jax, jax.numpy as jnp
from jax import lax
import numpy as np


D_MODEL = 1024
BATCH = 8
SEQ = 2048
DEPTH = 2

SWA_Q_HEADS = 8
SWA_KV_HEADS = 2
SWA_HEAD_DIM = 64
SWA_WINDOW = 128
SWA_BLOCK = 128
ROPE_THETA = 500000.0
ROPE_DIM = SWA_HEAD_DIM // 4
DN_HEADS = 4
DN_HEAD_DIM = 128
DN_CONV = 4
DN_CHUNK = 64
POOL_WINDOWS = (2, 4, 8, 16)
POOL_GROUP = D_MODEL // 4
N_EXPERTS = 32
TOP_K = 4
D_EXPERT = D_MODEL
SWIGLU_LIMIT = 7.0
SWIGLU_ALPHA = 1.702
LN_EPS = 1e-5
RMS_EPS = 1e-6
DEEPNORM_ALPHA = (2 * DEPTH) ** 0.25
DEEPNORM_BETA = (8 * DEPTH) ** -0.25
SWA_Q_WIDTH = SWA_Q_HEADS * SWA_HEAD_DIM
SWA_KV_WIDTH = SWA_KV_HEADS * SWA_HEAD_DIM
DN_WIDTH = DN_HEADS * DN_HEAD_DIM
IN_SIZES = (SWA_Q_WIDTH, SWA_KV_WIDTH, SWA_KV_WIDTH, 3 * DN_WIDTH, DN_WIDTH, DN_HEADS, DN_HEADS)
IN_WIDTH = sum(IN_SIZES)
MIX_WIDTH = SWA_Q_WIDTH + DN_WIDTH
N_EVEN = (DEPTH + 1) // 2
N_ODD = DEPTH // 2

kernel_name = 'hybrid_swa_deltanet_pool_moe'


def split_cols(t, sizes):
    out, start = [], 0
    for s in sizes:
        out.append(t[..., start:start + s])
        start += s
    return out


def layer_norm(x, g, b):
    xf = x.astype(jnp.float32)
    mu = xf.mean(-1, keepdims=True)
    var = jnp.square(xf - mu).mean(-1, keepdims=True)
    return ((xf - mu) * lax.rsqrt(var + LN_EPS) * g.astype(jnp.float32) + b.astype(jnp.float32)).astype(x.dtype)


def partial_rotary(x, positions):
    half = ROPE_DIM // 2
    inv_freq = ROPE_THETA ** (-jnp.arange(half, dtype=jnp.float32) / half)
    ang = positions.astype(jnp.float32)[:, :, None] * inv_freq
    cos = jnp.cos(ang)[:, :, None, :]
    sin = jnp.sin(ang)[:, :, None, :]
    xr = x[..., :ROPE_DIM].astype(jnp.float32)
    x1, x2 = xr[..., :half], xr[..., half:]
    rot = jnp.concatenate([x1 * cos - x2 * sin, x2 * cos + x1 * sin], axis=-1).astype(x.dtype)
    return jnp.concatenate([rot, x[..., ROPE_DIM:]], axis=-1)


def sliding_window_attention(q, k, v, sinks):
    B, T = q.shape[0], q.shape[1]
    nb = T // SWA_BLOCK
    G = SWA_Q_HEADS // SWA_KV_HEADS
    qb = q.reshape(B, nb, SWA_BLOCK, SWA_KV_HEADS, G, SWA_HEAD_DIM).astype(jnp.float32)

    def band(t):
        tb = t.reshape(B, nb, SWA_BLOCK, SWA_KV_HEADS, SWA_HEAD_DIM)
        prev = jnp.pad(tb, ((0, 0), (1, 0), (0, 0), (0, 0), (0, 0)))[:, :-1]
        return jnp.concatenate([prev, tb], axis=2)

    kb = band(k).astype(jnp.float32)
    vb = band(v)
    s = jnp.einsum('bnqhgd,bnkhd->bnhgqk', qb, kb) * (SWA_HEAD_DIM ** -0.5)
    qi = jnp.arange(SWA_BLOCK)[:, None]
    kj = jnp.arange(2 * SWA_BLOCK)[None, :]
    rel = qi + SWA_BLOCK - kj
    in_window = (rel >= 0) & (rel < SWA_WINDOW)
    key_pos = jnp.arange(nb)[:, None, None] * SWA_BLOCK - SWA_BLOCK + kj[None]
    valid = in_window[None] & (key_pos >= 0)
    s = jnp.where(valid[None, :, None, None], s, -jnp.inf)
    sink = sinks.astype(jnp.float32).reshape(SWA_KV_HEADS, G)[None, None, :, :, None, None]
    m = jnp.maximum(s.max(-1, keepdims=True), sink)
    p = jnp.exp(s - m)
    p = p / (p.sum(-1, keepdims=True) + jnp.exp(sink - m))
    o = jnp.einsum('bnhgqk,bnkhd->bnqhgd', p.astype(vb.dtype), vb)
    return o.reshape(B, T, SWA_Q_WIDTH)


def causal_depthwise_conv(x, w):
    K = w.shape[0]
    return lax.conv_general_dilated(x, w[:, None, :].astype(x.dtype), window_strides=(1,),
                                    padding=((K - 1, 0),), dimension_numbers=('NWC', 'WIO', 'NWC'),
                                    feature_group_count=x.shape[-1])


def l2norm(x):
    return x * lax.rsqrt(jnp.sum(x * x, axis=-1, keepdims=True) + RMS_EPS)


def gated_delta_rule(q, k, v, g, beta):
    B, T, H, Dk = k.shape
    Dv = v.shape[-1]
    C = DN_CHUNK
    n = T // C

    def chunks(t):
        return t.reshape((B, n, C) + t.shape[2:]).swapaxes(2, 3)

    q, k, v, g, beta = chunks(q), chunks(k), chunks(v), chunks(g), chunks(beta)
    gc = jnp.cumsum(g, axis=-1)
    causal = jnp.tril(jnp.ones((C, C), dtype=bool))
    strict = jnp.tril(jnp.ones((C, C), dtype=bool), -1)
    decay = jnp.exp(jnp.where(causal, gc[..., :, None] - gc[..., None, :], -jnp.inf))
    kk = jnp.einsum('bnhid,bnhjd->bnhij', k, k)
    a_strict = jnp.where(strict, beta[..., :, None] * kk * decay, 0.0)
    rhs = jnp.concatenate([v * beta[..., None], k * (beta * jnp.exp(gc))[..., None]], axis=-1)
    sol = lax.linalg.triangular_solve(a_strict, rhs, left_side=True, lower=True, unit_diagonal=True)
    u, w = sol[..., :Dv], sol[..., Dv:]
    qk = jnp.einsum('bnhid,bnhjd->bnhij', q, k) * decay
    q_dec = q * jnp.exp(gc)[..., None]
    k_dec = k * jnp.exp(gc[..., -1:] - gc)[..., None]
    g_last = jnp.exp(gc[..., -1])

    def step(S, inp):
        w_c, u_c, q_c, k_c, qk_c, gl = inp
        v_new = u_c - jnp.einsum('bhcd,bhde->bhce', w_c, S)
        o = jnp.einsum('bhcd,bhde->bhce', q_c, S) + jnp.einsum('bhij,bhje->bhie', qk_c, v_new)
        S = S * gl[..., None, None] + jnp.einsum('bhcd,bhce->bhde', k_c, v_new)
        return S, o

    xs = (w.swapaxes(0, 1), u.swapaxes(0, 1), q_dec.swapaxes(0, 1), k_dec.swapaxes(0, 1),
          qk.swapaxes(0, 1), g_last.swapaxes(0, 1))
    S0 = jnp.zeros((B, H, Dk, Dv), jnp.float32)
    _, o = lax.scan(step, S0, xs)
    return o.transpose(1, 0, 3, 2, 4).reshape(B, T, H, Dv)


def mixer_swa_deltanet(x, positions, w_in, b_in, conv_w, a_log, dt_bias, norm_w, sinks, w_out, b_out):
    B, T, _ = x.shape
    proj = x @ w_in + b_in
    sq, sk, sv, dqkv, dz, da, db = split_cols(proj, IN_SIZES)
    q = partial_rotary(sq.reshape(B, T, SWA_Q_HEADS, SWA_HEAD_DIM), positions)
    k = partial_rotary(sk.reshape(B, T, SWA_KV_HEADS, SWA_HEAD_DIM), positions)
    v = sv.reshape(B, T, SWA_KV_HEADS, SWA_HEAD_DIM)
    a_out = sliding_window_attention(q, k, v, sinks)
    dqkv = jax.nn.silu(causal_depthwise_conv(dqkv, conv_w)).astype(jnp.float32)
    dq, dk, dv = split_cols(dqkv, (DN_WIDTH, DN_WIDTH, DN_WIDTH))
    dq = l2norm(dq.reshape(B, T, DN_HEADS, DN_HEAD_DIM)) * (DN_HEAD_DIM ** -0.5)
    dk = l2norm(dk.reshape(B, T, DN_HEADS, DN_HEAD_DIM))
    dv = dv.reshape(B, T, DN_HEADS, DN_HEAD_DIM)
    beta = jax.nn.sigmoid(db.astype(jnp.float32))
    g = -jnp.exp(a_log.astype(jnp.float32)) * jax.nn.softplus(da.astype(jnp.float32) + dt_bias.astype(jnp.float32))
    o = gated_delta_rule(dq, dk, dv, g, beta)
    z = dz.reshape(B, T, DN_HEADS, DN_HEAD_DIM).astype(jnp.float32)
    o = o * lax.rsqrt(jnp.mean(o * o, axis=-1, keepdims=True) + RMS_EPS) * norm_w.astype(jnp.float32) * jax.nn.silu(z)
    dn_out = o.reshape(B, T, DN_WIDTH).astype(x.dtype)
    return jnp.concatenate([a_out, dn_out], axis=-1) @ w_out + b_out


def multiscale_pool(x, pool_w, pool_b, pool_scale):
    B, T, D = x.shape
    xf = x.astype(jnp.float32)
    cs = jnp.pad(jnp.cumsum(xf, axis=1), ((0, 0), (1, 0), (0, 0)))
    t = jnp.arange(T)
    outs = []
    for gi, win in enumerate(POOL_WINDOWS):
        lo = jnp.maximum(t + 1 - win, 0)
        cnt = (t + 1 - lo).astype(jnp.float32)[None, :, None]
        csg = cs[..., gi * POOL_GROUP:(gi + 1) * POOL_GROUP]
        mean = (csg[:, 1:] - csg[:, lo]) / cnt
        outs.append(mean - xf[..., gi * POOL_GROUP:(gi + 1) * POOL_GROUP])
    pooled = jnp.stack(outs, axis=2).astype(x.dtype)
    y = jnp.einsum('btgc,gcd->btgd', pooled, pool_w) + pool_b
    return y.reshape(B, T, D) * pool_scale


def moe(x, router_w, router_b, w1, b1, w2, b2):
    B, T, D = x.shape
    xt = x.reshape(B * T, D)
    logits = (xt @ router_w + router_b).astype(jnp.float32)
    top_v, top_i = lax.top_k(logits, TOP_K)
    top_w = jax.nn.softmax(top_v, axis=-1)
    y = jnp.zeros((B * T, D), jnp.float32)
    for e in range(N_EXPERTS):
        gate = jnp.sum(jnp.where(top_i == e, top_w, 0.0), axis=-1)
        h = xt @ w1[e] + b1[e]
        h_glu = jnp.minimum(h[:, 0::2], SWIGLU_LIMIT)
        h_lin = jnp.clip(h[:, 1::2], -SWIGLU_LIMIT, SWIGLU_LIMIT)
        act = h_glu * jax.nn.sigmoid(SWIGLU_ALPHA * h_glu) * (h_lin + 1.0)
        y = y + gate[:, None] * (act @ w2[e] + b2[e]).astype(jnp.float32)
    return y.astype(x.dtype).reshape(B, T, D)


def setup_inputs(seed: int = 0) -> dict:
    key = jax.random.key(seed)
    ks = jax.random.split(key, 24)
    f32 = jnp.float32

    def nrm(k, shape, scale):
        return jax.random.normal(k, shape, f32) * scale

    x = jax.random.normal(ks[0], (BATCH, SEQ, D_MODEL), f32)
    offset = jax.random.randint(ks[1], (BATCH, 1), 0, 4096, dtype=jnp.int32)
    positions = offset + jnp.arange(SEQ, dtype=jnp.int32)[None, :]
    mix_w_in = nrm(ks[2], (N_EVEN, D_MODEL, IN_WIDTH), D_MODEL ** -0.5)
    mix_b_in = nrm(ks[3], (N_EVEN, IN_WIDTH), 0.01)
    dn_conv_w = nrm(ks[4], (N_EVEN, DN_CONV, 3 * DN_WIDTH), DN_CONV ** -0.5)
    dn_a_log = jnp.log(jax.random.uniform(ks[5], (N_EVEN, DN_HEADS), f32, 1.0, 16.0))
    dt = jnp.exp(jax.random.uniform(ks[6], (N_EVEN, DN_HEADS), f32, math.log(1e-3), math.log(1e-1)))
    dn_dt_bias = dt + jnp.log(-jnp.expm1(-dt))
    dn_norm_w = 1.0 + nrm(ks[7], (N_EVEN, DN_HEAD_DIM), 0.02)
    swa_sinks = nrm(ks[8], (N_EVEN, SWA_Q_HEADS), 1.0)
    mix_w_out = nrm(ks[9], (N_EVEN, MIX_WIDTH, D_MODEL), DEEPNORM_BETA * MIX_WIDTH ** -0.5)
    mix_b_out = nrm(ks[10], (N_EVEN, D_MODEL), 0.01)
    pool_w = nrm(ks[11], (N_ODD, len(POOL_WINDOWS), POOL_GROUP, POOL_GROUP), DEEPNORM_BETA * POOL_GROUP ** -0.5)
    pool_b = nrm(ks[12], (N_ODD, len(POOL_WINDOWS), POOL_GROUP), 0.01)
    pool_scale = 1.0 + nrm(ks[13], (N_ODD, D_MODEL), 0.02)
    ln1_g = 1.0 + nrm(ks[14], (DEPTH, D_MODEL), 0.02)
    ln1_b = nrm(ks[15], (DEPTH, D_MODEL), 0.01)
    router_w = nrm(ks[16], (DEPTH, D_MODEL, N_EXPERTS), D_MODEL ** -0.5)
    router_b = nrm(ks[17], (DEPTH, N_EXPERTS), 0.01)
    moe_w1 = nrm(ks[18], (DEPTH, N_EXPERTS, D_MODEL, 2 * D_EXPERT), D_MODEL ** -0.5)
    moe_b1 = nrm(ks[19], (DEPTH, N_EXPERTS, 2 * D_EXPERT), 0.01)
    moe_w2 = nrm(ks[20], (DEPTH, N_EXPERTS, D_EXPERT, D_MODEL), DEEPNORM_BETA * D_EXPERT ** -0.5)
    moe_b2 = nrm(ks[21], (DEPTH, N_EXPERTS, D_MODEL), 0.01)
    ln2_g = 1.0 + nrm(ks[22], (DEPTH, D_MODEL), 0.02)
    ln2_b = nrm(ks[23], (DEPTH, D_MODEL), 0.01)
    return {'x': x, 'positions': positions, 'mix_w_in': mix_w_in, 'mix_b_in': mix_b_in,
            'dn_conv_w': dn_conv_w, 'dn_a_log': dn_a_log, 'dn_dt_bias': dn_dt_bias, 'dn_norm_w': dn_norm_w,
            'swa_sinks': swa_sinks, 'mix_w_out': mix_w_out, 'mix_b_out': mix_b_out,
            'pool_w': pool_w, 'pool_b': pool_b, 'pool_scale': pool_scale,
            'ln1_g': ln1_g, 'ln1_b': ln1_b, 'router_w': router_w, 'router_b': router_b,
            'moe_w1': moe_w1, 'moe_b1': moe_b1, 'moe_w2': moe_w2, 'moe_b2': moe_b2,
            'ln2_g': ln2_g, 'ln2_b': ln2_b}


def reference(x, positions, mix_w_in, mix_b_in, dn_conv_w, dn_a_log, dn_dt_bias, dn_norm_w,
              swa_sinks, mix_w_out, mix_b_out, pool_w, pool_b, pool_scale,
              ln1_g, ln1_b, router_w, router_b, moe_w1, moe_b1, moe_w2, moe_b2, ln2_g, ln2_b):
    for layer in range(DEPTH):
        i = layer // 2
        if layer % 2 == 0:
            h = mixer_swa_deltanet(x, positions, mix_w_in[i], mix_b_in[i], dn_conv_w[i], dn_a_log[i],
                                   dn_dt_bias[i], dn_norm_w[i], swa_sinks[i], mix_w_out[i], mix_b_out[i])
        else:
            h = multiscale_pool(x, pool_w[i], pool_b[i], pool_scale[i])
        x = layer_norm(DEEPNORM_ALPHA * x + h, ln1_g[layer], ln1_b[layer])
        f = moe(x, router_w[layer], router_b[layer], moe_w1[layer], moe_b1[layer], moe_w2[layer], moe_b2[layer])
        x = layer_norm(DEEPNORM_ALPHA * x + f, ln2_g[layer], ln2_b[layer])
    return x
```

```cpp
#include <hip/hip_runtime.h>
#include <cstdio>
#include <cstdint>

#ifndef MK_N_LAUNCHES
#define MK_N_LAUNCHES 1
#endif

namespace pg8 {
#define PG8_LAS __attribute__((address_space(3)))
typedef unsigned short bf16_t;
typedef short bf16x8 __attribute__((ext_vector_type(8)));
typedef float f32x4 __attribute__((ext_vector_type(4)));
typedef unsigned u32x4 __attribute__((ext_vector_type(4)));
typedef unsigned u32x2 __attribute__((ext_vector_type(2)));
constexpr int BM = 256, BK = 64, HALF = 128, HTB = HALF * BK * 2  , STAGE_BYTES = 8 * HTB, NXCD = 8, WGM = 8;

__host__ __device__ __forceinline__ int lds_byte(int r, int c) { const int st = (r >> 4) * 2 + (c >> 5), rr = r & 15, cc = c & 31, ob = rr * 64 + cc * 2; return st * 1024 + (ob ^ (((ob >> 9) & 1) << 5)); }
__host__ __device__ __forceinline__ void stage_rc(int b, int& R, int& C) { const int st = b / 1024, sb = b % 1024, swz = sb ^ (((sb >> 9) & 1) << 5); R = (st >> 1) * 16 + swz / 64; C = (st & 1) * 32 + (swz % 64) / 2; }
__host__ __device__ __forceinline__ int perm32(int rho) { const int n = rho >> 4, i = rho & 15; return 8 * (i >> 2) + 4 * n + (i & 3); }

struct Unit { int pm, pn, aoff; };
struct Gemm { const bf16_t* A; const bf16_t* Bt; int K, lda, ldb; };

struct StaticOrder {
    int nM, nN, nwg, G, c;
    __host__ __device__ void init(int M, int N, int G_, int c_) { nM = M / BM; nN = N / BM; nwg = nM * nN; G = G_; c = c_; }
    __host__ __device__ bool next(int i, Unit& u) const {
        const long L = (long)i * G + c; if (L >= nwg) return false;
        int wgid = (int)L; { const int q = nwg / NXCD, r = nwg % NXCD, xcd = wgid % NXCD, off = wgid / NXCD; wgid = (xcd < r ? xcd * (q + 1) : r * (q + 1) + (xcd - r) * q) + off; }
        const int nig = WGM * nN, gid = wgid / nig, fm = gid * WGM, gsz = (nM - fm) < WGM ? (nM - fm) : WGM;
        u.pm = fm + ((wgid % nig) % gsz); u.pn = (wgid % nig) / gsz; u.aoff = 0; return true;
    }
};
struct PoolOrder {
    int G, c;
    __device__ bool next(int i, Unit& u) const { const int L = i * G + c; if (L >= 256) return false; u.pm = L >> 2; u.pn = L & 3; u.aoff = (L & 3) * 256 * 2; return true; }
};
struct GroupedOrder {
    const int* tile_e; int ntiles, nN, G, c;
    __device__ bool next(int i, Unit& u) const {
        int pm, pnl;
        if (G == 256) { const int x = c & 7, j = c >> 3, s = i * 8 + x; if (nN == 8) { pm = 4 * s + (j >> 3); pnl = j & 7; } else { pm = 8 * s + (j >> 2); pnl = j & 3; } }
        else { const int L = i * G + c; pm = L / nN; pnl = L % nN; }
        if (pm >= ntiles) return false;
        const int e = tile_e[pm]; u.pm = pm; u.pn = e * nN + pnl; u.aoff = 0; return true;
    }
};

__device__ __forceinline__ unsigned cvt_pk_bf16(float lo, float hi) { unsigned r; asm volatile("v_cvt_pk_bf16_f32 %0, %1, %2" : "=v"(r) : "v"(lo), "v"(hi)); return r; }

struct EpiF32 {
    static constexpr bool PERM = false;
    float* C; int ldc; const float* bias; const float* scale;
    __device__ __forceinline__ void operator()(const f32x4 (&acc)[2][2][4][2], const Unit& u, int wr, int wc, int fr, int fq) const {
        const int row0 = u.pm * BM + wr * 64 + fr, col0 = u.pn * BM + wc * 32 + 4 * fq;
        f32x4 bv[2][2], sv[2][2];
#pragma unroll
        for (int bj = 0; bj < 2; ++bj)
#pragma unroll
            for (int n = 0; n < 2; ++n) { bv[bj][n] = bias ? *(const f32x4*)(bias + col0 + bj * HALF + n * 16) : (f32x4){0.f, 0.f, 0.f, 0.f};
                                          sv[bj][n] = scale ? *(const f32x4*)(scale + col0 + bj * HALF + n * 16) : (f32x4){1.f, 1.f, 1.f, 1.f}; }
#pragma unroll
        for (int ai = 0; ai < 2; ++ai)
#pragma unroll
            for (int m = 0; m < 4; ++m) { float* rowp = C + (size_t)(row0 + ai * HALF + m * 16) * ldc + col0;
#pragma unroll
                for (int bj = 0; bj < 2; ++bj)
#pragma unroll
                    for (int n = 0; n < 2; ++n) *(f32x4*)(rowp + bj * HALF + n * 16) = (acc[ai][bj][m][n] + bv[bj][n]) * sv[bj][n]; }
    }
};
struct EpiYS {
    static constexpr bool PERM = false;
    float* C; const float* b2;
    __device__ __forceinline__ void operator()(const f32x4 (&acc)[2][2][4][2], const Unit& u, int wr, int wc, int fr, int fq) const {
        const int e = u.pn >> 2, pnl = u.pn & 3;
        const int row0 = u.pm * BM + wr * 64 + fr, col0 = pnl * BM + wc * 32 + 4 * fq;
        const float* bias = b2 + e * 1024;
        f32x4 bv[2][2];
#pragma unroll
        for (int bj = 0; bj < 2; ++bj)
#pragma unroll
            for (int n = 0; n < 2; ++n) bv[bj][n] = *(const f32x4*)(bias + col0 + bj * HALF + n * 16);
#pragma unroll
        for (int ai = 0; ai < 2; ++ai)
#pragma unroll
            for (int m = 0; m < 4; ++m) { float* rowp = C + (size_t)(row0 + ai * HALF + m * 16) * 1024 + col0;
#pragma unroll
                for (int bj = 0; bj < 2; ++bj)
#pragma unroll
                    for (int n = 0; n < 2; ++n) *(f32x4*)(rowp + bj * HALF + n * 16) = acc[ai][bj][m][n] + bv[bj][n]; }
    }
};
struct EpiSwiGLU {
    static constexpr bool PERM = true;
    bf16_t* O; const float* b1;
    __device__ __forceinline__ void operator()(const f32x4 (&acc)[2][2][4][2], const Unit& u, int wr, int wc, int fr, int fq) const {
        const int e = u.pn >> 3, pnl = u.pn & 7;
        const int row0 = u.pm * BM + wr * 64 + fr, col0 = pnl * BM + wc * 32 + 8 * fq;
        const float* bias = b1 + e * 2048;
        f32x4 bv[2][2];
#pragma unroll
        for (int bj = 0; bj < 2; ++bj)
#pragma unroll
            for (int n = 0; n < 2; ++n) bv[bj][n] = *(const f32x4*)(bias + col0 + bj * HALF + 4 * n);
#pragma unroll
        for (int ai = 0; ai < 2; ++ai)
#pragma unroll
            for (int m = 0; m < 4; ++m) { bf16_t* rowp = O + (size_t)(row0 + ai * HALF + m * 16) * 1024 + (col0 >> 1);
#pragma unroll
                for (int bj = 0; bj < 2; ++bj) { const f32x4 v0 = acc[ai][bj][m][0] + bv[bj][0], v1 = acc[ai][bj][m][1] + bv[bj][1];
                    float g[4] = {v0[0], v0[2], v1[0], v1[2]}, l[4] = {v0[1], v0[3], v1[1], v1[3]}, a[4];
#pragma unroll
                    for (int q = 0; q < 4; ++q) { const float hg = fminf(g[q], 7.0f), hl = fminf(fmaxf(l[q], -7.0f), 7.0f);
                        a[q] = hg * (1.0f / (1.0f + __expf(-1.702f * hg))) * (hl + 1.0f); }
                    u32x2 w; w.x = cvt_pk_bf16(a[0], a[1]); w.y = cvt_pk_bf16(a[2], a[3]);
                    *(u32x2*)(rowp + bj * (HALF / 2)) = w; } }
    }
};

template <class Epi, class Sched>
__device__ __forceinline__ void gemm_phase(PG8_LAS unsigned char* lds, const Gemm g, const Sched& S, const Epi& E) {
    int tid = threadIdx.x; asm volatile("" : "+v"(tid));
    const int wid = __builtin_amdgcn_readfirstlane(tid >> 6), lane = tid & 63, wr = wid >> 2, wc = wid & 3, fr = lane & 15, fq = lane >> 4;
    int K = g.K; asm volatile("" : "+s"(K)); const int nt = K / BK;
    unsigned voffA[2], voffB[2];
#pragma unroll
    for (int i = 0; i < 2; ++i) { int R, C; stage_rc(tid * 16 + i * 8192, R, C); const int Rb = Epi::PERM ? ((R & ~31) + perm32(R & 31)) : R;
        voffA[i] = (unsigned)(R * g.lda + C) * 2u; voffB[i] = (unsigned)(Rb * g.ldb + C) * 2u; }
    const size_t kstep = (size_t)(BK * 2);
    const size_t hstepA = (size_t)HALF * g.lda * 2, hstepB = (size_t)HALF * g.ldb * 2;
    const size_t tstepA = 2 * hstepA, tstepB = 2 * hstepB;
    const unsigned ldsw = (unsigned)wid * 1024u;
    const int aoff = lds_byte(wr * 64 + fr, fq * 8), boff = lds_byte(wc * 32 + fr, fq * 8);
#define PG8_SA(b, h) (((b) * 2 + (h)) * HTB)
#define PG8_SB(b, h) ((4 + (b) * 2 + (h)) * HTB)
#define PG8_STAGE(bufoff, gbase, voff) do { _Pragma("unroll") for (int _i = 0; _i < 2; ++_i) \
        __builtin_amdgcn_global_load_lds((const unsigned*)((const char*)(gbase) + (voff)[_i]), (PG8_LAS unsigned*)(lds + (bufoff) + ldsw + _i * 8192), 16, 0, 0); } while (0)
#define PG8_LDA(dst, b, h) do { _Pragma("unroll") for (int m = 0; m < 4; ++m) _Pragma("unroll") for (int k = 0; k < 2; ++k) dst[m][k] = *(const PG8_LAS bf16x8*)(lds + PG8_SA(b, h) + aoff + m * 2048 + k * 1024); } while (0)
#define PG8_LDB(dst, b, h) do { _Pragma("unroll") for (int n = 0; n < 2; ++n) _Pragma("unroll") for (int k = 0; k < 2; ++k) dst[n][k] = *(const PG8_LAS bf16x8*)(lds + PG8_SB(b, h) + boff + n * 2048 + k * 1024); } while (0)
#define PG8_MMA(ai, bj, At, Bt) do { __builtin_amdgcn_s_setprio(1); _Pragma("unroll") for (int m = 0; m < 4; ++m) _Pragma("unroll") for (int n = 0; n < 2; ++n) _Pragma("unroll") for (int k = 0; k < 2; ++k) \
        acc[ai][bj][m][n] = __builtin_amdgcn_mfma_f32_16x16x32_bf16(Bt[n][k], At[m][k], acc[ai][bj][m][n], 0, 0, 0); __builtin_amdgcn_s_setprio(0); } while (0)
#define PG8_WAIT_V(n) asm volatile("s_waitcnt vmcnt(" #n ")" ::: "memory")
#define PG8_WAIT_L(n) asm volatile("s_waitcnt lgkmcnt(" #n ")" ::: "memory")
#define PG8_BAR __builtin_amdgcn_s_barrier()
#define PG8_SCHED __builtin_amdgcn_sched_barrier(0)
    Unit cur, nxt; int ui = 0;
    if (!S.next(0, cur)) return;
    f32x4 acc[2][2][4][2];
#pragma unroll
    for (int a = 0; a < 2; ++a)
#pragma unroll
        for (int b = 0; b < 2; ++b)
#pragma unroll
            for (int m = 0; m < 4; ++m)
#pragma unroll
                for (int n = 0; n < 2; ++n) acc[a][b][m][n] = (f32x4){0.f, 0.f, 0.f, 0.f};
    bf16x8 At[4][2], B0[2][2], B1[2][2];
    const char* cA = (const char*)g.A + (size_t)cur.pm * tstepA + cur.aoff; const char* cB = (const char*)g.Bt + (size_t)cur.pn * tstepB;
    PG8_STAGE(PG8_SB(0, 0), cB, voffB); PG8_STAGE(PG8_SB(0, 1), cB + hstepB, voffB); PG8_STAGE(PG8_SA(0, 0), cA, voffA); PG8_STAGE(PG8_SA(0, 1), cA + hstepA, voffA);
    if (wr == 1) PG8_BAR;
    PG8_WAIT_V(2); PG8_BAR;
    PG8_STAGE(PG8_SB(1, 0), cB + kstep, voffB); PG8_STAGE(PG8_SA(1, 0), cA + kstep, voffA); PG8_STAGE(PG8_SB(1, 1), cB + hstepB + kstep, voffB);
    PG8_WAIT_V(6); PG8_BAR;
    for (;;) {
        const bool has_next = S.next(ui + 1, nxt);
        const char* nA = has_next ? (const char*)g.A + (size_t)nxt.pm * tstepA + nxt.aoff : cA; const char* nB = has_next ? (const char*)g.Bt + (size_t)nxt.pn * tstepB : cB;
        for (int t = 0; t < nt; t += 2) {
            const bool last = (t == nt - 2);
            const char* a1 = cA + (size_t)(t + 1) * kstep;
            const char* a2 = last ? nA : cA + (size_t)(t + 2) * kstep; const char* b2 = last ? nB : cB + (size_t)(t + 2) * kstep;
            const char* a3 = a2 + kstep; const char* b3 = b2 + kstep;
            PG8_LDB(B0, 0, 0); PG8_LDB(B1, 0, 1); PG8_SCHED; PG8_LDA(At, 0, 0); PG8_STAGE(PG8_SA(1, 1), a1 + hstepA, voffA);
            PG8_WAIT_V(8); PG8_WAIT_L(0); PG8_BAR; PG8_MMA(0, 0, At, B0); PG8_MMA(0, 1, At, B1); PG8_BAR; PG8_SCHED;
            PG8_LDA(At, 0, 1); PG8_STAGE(PG8_SB(0, 0), b2, voffB); PG8_STAGE(PG8_SB(0, 1), b2 + hstepB, voffB); PG8_STAGE(PG8_SA(0, 0), a2, voffA);
            PG8_WAIT_V(8); PG8_WAIT_L(0); PG8_BAR; PG8_MMA(1, 0, At, B0); PG8_MMA(1, 1, At, B1); PG8_BAR; PG8_SCHED;
            PG8_LDB(B0, 1, 0); PG8_LDB(B1, 1, 1); PG8_SCHED; PG8_LDA(At, 1, 0); PG8_STAGE(PG8_SA(0, 1), a2 + hstepA, voffA);
            PG8_WAIT_V(8); PG8_WAIT_L(0); PG8_BAR; PG8_MMA(0, 0, At, B0); PG8_MMA(0, 1, At, B1); PG8_BAR; PG8_SCHED;
            PG8_LDA(At, 1, 1); PG8_STAGE(PG8_SB(1, 0), b3, voffB); PG8_STAGE(PG8_SB(1, 1), b3 + hstepB, voffB); PG8_STAGE(PG8_SA(1, 0), a3, voffA);
            PG8_WAIT_V(8); PG8_WAIT_L(0); PG8_BAR; PG8_MMA(1, 0, At, B0); PG8_MMA(1, 1, At, B1); PG8_BAR; PG8_SCHED;
        }
        if (wr == 0) PG8_BAR;
        E(acc, cur, wr, wc, fr, fq);
        if (!has_next) break;
#pragma unroll
        for (int a = 0; a < 2; ++a)
#pragma unroll
            for (int b = 0; b < 2; ++b)
#pragma unroll
                for (int m = 0; m < 4; ++m)
#pragma unroll
                    for (int n = 0; n < 2; ++n) acc[a][b][m][n] = (f32x4){0.f, 0.f, 0.f, 0.f};
        cur = nxt; cA = nA; cB = nB; ++ui;
        if (wr == 1) PG8_BAR;
    }
    PG8_WAIT_V(0);
    PG8_BAR;
#undef PG8_SA
#undef PG8_SB
#undef PG8_STAGE
#undef PG8_LDA
#undef PG8_LDB
#undef PG8_MMA
#undef PG8_WAIT_V
#undef PG8_WAIT_L
#undef PG8_BAR
#undef PG8_SCHED
}
}

constexpr int NWAVES = 8;
constexpr int D = 1024, SEQ = 2048, NB = 8, M = NB * SEQ;
constexpr int INW = 2824, INW_G = 2816;
constexpr int C_Q = 0, C_K = 512, C_V = 640, C_DQKV = 768, C_DZ = 2304;
constexpr int NE = 32, TOPK = 4, DE2 = 2048;
constexpr float ALPHA = 1.41421356237309515f;
constexpr float LN_EPS = 1e-5f, RMS_EPS = 1e-6f;
constexpr int MPAD_MAX = M * TOPK + NE * 256;

constexpr size_t MiB = 1u << 20;
constexpr size_t WS_CTL = 0, CTL_ZERO_BYTES = 1 * MiB;
constexpr size_t WS_META = 1 * MiB;
constexpr size_t WS_WIN = 2 * MiB, WS_WOUT = 8 * MiB, WS_PW = 10 * MiB;
constexpr size_t WS_W1 = 16 * MiB, WS_W2 = 272 * MiB;
constexpr size_t WS_XB = 400 * MiB;
constexpr size_t WS_DAB = 432 * MiB;
constexpr size_t WS_G = 433 * MiB, WS_BETA = 434 * MiB;
constexpr size_t WS_TOPI = 435 * MiB, WS_TOPW = 436 * MiB, WS_TOKPOS = 437 * MiB, WS_SORTED = 438 * MiB;
constexpr size_t WS_MIX = 440 * MiB;
constexpr size_t WS_H = 472 * MiB;
constexpr size_t WS_X1 = 536 * MiB, WS_X2 = 600 * MiB;
constexpr size_t WS_POOLED = 664 * MiB;
constexpr size_t WS_SCR = 696 * MiB;
constexpr size_t WS_PROJ = WS_SCR;
constexpr size_t WS_QN = WS_SCR + 176 * MiB, WS_KN = WS_QN + 32 * MiB, WS_VV = WS_KN + 32 * MiB, WS_OO = WS_VV + 32 * MiB;
constexpr size_t WS_XPERM = WS_SCR;
constexpr size_t WS_ACT = WS_SCR + 144 * MiB;
constexpr size_t WS_YS = WS_SCR + 288 * MiB;
constexpr size_t WS_END = WS_SCR + 576 * MiB;
constexpr int META_BHIST = 0, META_TILE_E = 8192, META_NTILES = 8192 + 512;

constexpr int CW_BAR = 4096;
constexpr int RING_OFF = 0, RING_BYTES = 131072;
constexpr int LDSCTL_OFF = RING_BYTES, MISC_OFF = LDSCTL_OFF + 320;
constexpr int LDS_BYTES = 147456;

#define GAS __attribute__((address_space(1)))
#define LAS __attribute__((address_space(3)))
typedef unsigned short bf16;
typedef unsigned v4u __attribute__((ext_vector_type(4)));
typedef unsigned v2u __attribute__((ext_vector_type(2)));
typedef float f32x4 __attribute__((ext_vector_type(4)));
#define LDS_WAIT() asm volatile("s_waitcnt lgkmcnt(0)" ::: "memory")
__device__ __forceinline__ unsigned f2bf(float f) { unsigned u = __builtin_bit_cast(unsigned, f); return (u + 0x7fffu + ((u >> 16) & 1u)) >> 16; }
__device__ __forceinline__ unsigned pk2(float lo, float hi) { return f2bf(lo) | (f2bf(hi) << 16); }

#define XB_TMO      128
#define XB_XCNT(j)  (256  + 64 * (j))
#define XB_XSUB(j)  (1280 + 64 * (j))
#define XB_XGEN(j)  (2304 + 64 * (j))
#define XB_TOP      3328
#define XB_TOPGEN   3392
#define XCD_BAR_WORDS 3456
#define XB_SPIN_CAP (1u << 18)
__device__ __forceinline__ unsigned xb_ld(unsigned* p)              { return __hip_atomic_load(p, __ATOMIC_RELAXED, __HIP_MEMORY_SCOPE_AGENT); }
__device__ __forceinline__ unsigned xb_add(unsigned* p, unsigned v) { return __hip_atomic_fetch_add(p, v, __ATOMIC_RELAXED, __HIP_MEMORY_SCOPE_AGENT); }
__device__ __forceinline__ unsigned xb_xcc_id() { return (unsigned)__builtin_amdgcn_s_getreg((3 << 11) | 20) & 0xFu; }
#define XB_SPIN(cond, bar) do { unsigned _sp = 0; while (cond) { __builtin_amdgcn_s_sleep(1); \
    if ((++_sp & 255u) == 0u) { if (xb_ld(&(bar)[XB_TMO])) break; if (_sp > XB_SPIN_CAP) { atomicAdd(&(bar)[XB_TMO], 1u); break; } } } } while (0)
struct XcdBarrier { unsigned* bar; unsigned x; volatile LAS unsigned* st; };
__device__ __forceinline__ XcdBarrier xcd_barrier_post(unsigned* bar, volatile LAS unsigned* st) {
    XcdBarrier b; b.bar = bar; b.x = xb_xcc_id(); b.st = st;
    if (threadIdx.x == 0) (void)xb_add(&bar[XB_XCNT(b.x)], 1u);
    return b;
}
__device__ __forceinline__ void xcd_barrier_complete(unsigned* bar, unsigned x, unsigned& nloc, unsigned& nx) {
    const unsigned G = gridDim.x * gridDim.y * gridDim.z;
    unsigned sum, cnt, mine, sp = 0u;
    for (;;) {
        sum = 0u; cnt = 0u; mine = 0u;
#pragma unroll
        for (unsigned j = 0; j < 16; ++j) { const unsigned c = xb_ld(&bar[XB_XCNT(j)]); sum += c; cnt += (c > 0u) ? 1u : 0u; mine = (j == x) ? c : mine; }
        if (sum == G) break;
        __builtin_amdgcn_s_sleep(1);
        if ((++sp & 255u) == 0u) { if (xb_ld(&bar[XB_TMO])) break; if (sp > XB_SPIN_CAP) { atomicAdd(&bar[XB_TMO], 1u); break; } }
    }
    nloc = mine > 0u ? mine : 1u; nx = cnt > 0u ? cnt : 1u;
}
__device__ __forceinline__ void xcd_barrier(const XcdBarrier& b) {
    asm volatile("s_waitcnt vmcnt(0)" ::: "memory");
    __syncthreads();
    if (threadIdx.x == 0) {
        unsigned* bar = b.bar;
        __builtin_amdgcn_s_waitcnt(0);
        unsigned nloc = b.st[0], nx = b.st[1];
        if (nloc == 0u) { xcd_barrier_complete(bar, b.x, nloc, nx); b.st[0] = nloc; b.st[1] = nx; }
        const unsigned old = xb_add(&bar[XB_XSUB(b.x)], 1u);
        const unsigned gen = old / nloc;
        if (old + 1u == (gen + 1u) * nloc) {
            __builtin_amdgcn_fence(__ATOMIC_RELEASE, "agent");
            asm volatile("s_waitcnt vmcnt(0)" ::: "memory");
            const unsigned og = xb_add(&bar[XB_TOP], 1u);
            const unsigned tg = og / nx;
            if (og + 1u == (tg + 1u) * nx) xb_add(&bar[XB_TOPGEN], 1u);
            else XB_SPIN(xb_ld(&bar[XB_TOPGEN]) == tg, bar);
            __builtin_amdgcn_fence(__ATOMIC_ACQUIRE, "agent");
            xb_add(&bar[XB_XGEN(b.x)], 1u);
            asm volatile("s_waitcnt vmcnt(0)" ::: "memory");
        } else {
            XB_SPIN(xb_ld(&bar[XB_XGEN(b.x)]) == gen, bar);
            __builtin_amdgcn_fence(__ATOMIC_ACQUIRE, "agent");
            asm volatile("s_waitcnt vmcnt(0)" ::: "memory");
        }
    }
    __syncthreads();
}

__device__ __forceinline__ float wave_sum(float v) {
#pragma unroll
    for (int o = 1; o < 64; o <<= 1) v += __shfl_xor(v, o);
    return v;
}
__device__ __forceinline__ float wave_max(float v) {
#pragma unroll
    for (int o = 1; o < 64; o <<= 1) v = fmaxf(v, __shfl_xor(v, o));
    return v;
}
__device__ __forceinline__ float sigmoidf_(float x) { return 1.0f / (1.0f + expf(-x)); }
__device__ __forceinline__ float siluf_(float x) { return x * sigmoidf_(x); }

__device__ __forceinline__ void p0_transpose_item(const float* W, int K, int ldw, int nblk, bf16* WT, LAS float* scr, int item, int lane) {
    const int kb = item / nblk, nb = item % nblk, k0 = 64 * kb, n0 = 32 * nb;
#pragma unroll 8
    for (int i = 0; i < 32; ++i) { const int kk = 2 * i + (lane >> 5); scr[kk * 33 + (lane & 31)] = W[(size_t)(k0 + kk) * ldw + n0 + (lane & 31)]; }
    LDS_WAIT(); asm volatile("" ::: "memory");
    const int c = lane & 7;
#pragma unroll
    for (int j = 0; j < 4; ++j) { const int n = (lane >> 3) + 8 * j; const LAS float* s = scr + (8 * c) * 33 + n;
        v4u o; o.x = pk2(s[0 * 33], s[1 * 33]); o.y = pk2(s[2 * 33], s[3 * 33]); o.z = pk2(s[4 * 33], s[5 * 33]); o.w = pk2(s[6 * 33], s[7 * 33]);
        *(GAS v4u*)(WT + (size_t)(n0 + n) * K + k0 + 8 * c) = o; }
    LDS_WAIT(); asm volatile("" ::: "memory");
}

struct Args { const float* in[24]; float* out; unsigned char* ws; int ph_lo, ph_hi; };

typedef const __attribute__((address_space(4))) Args CArgs;
__device__ __forceinline__ CArgs* kargs() { CArgs* p = (CArgs*)__builtin_amdgcn_kernarg_segment_ptr(); asm volatile("" : "+s"(p)); return p; }
#define PH_BEGIN CArgs* A_ = kargs(); unsigned char* ws = A_->ws; (void)ws; int tid_l_ = threadIdx.x; asm volatile("" : "+v"(tid_l_)); const int tid = tid_l_, lane = tid_l_ & 63; (void)tid; (void)lane;
#define INP(i) (A_->in[i])
#define WSP(T, off) ((T*)(ws + (off)))
__global__ void __launch_bounds__(NWAVES * 64, 2) hybrid_fwd(Args args) {
    extern __shared__ __attribute__((aligned(16))) unsigned char lds[];
    LAS unsigned char* L = (LAS unsigned char*)lds;
    volatile LAS unsigned* MISC = (volatile LAS unsigned*)(L + MISC_OFF);
    const int tid = threadIdx.x, lane = tid & 63, wave = __builtin_amdgcn_readfirstlane(tid >> 6);
    const int G = gridDim.x, blk = blockIdx.x;
    const int gw = blk * NWAVES + wave, NGW = G * NWAVES;
    unsigned* ctl = (unsigned*)(args.ws + WS_CTL);
    for (int u = tid; u < (LDS_BYTES - LDSCTL_OFF) / 4; u += NWAVES * 64) ((LAS unsigned*)(L + LDSCTL_OFF))[u] = 0u;
    __syncthreads();
    XcdBarrier bar; bar.bar = ctl + CW_BAR; bar.x = 0; bar.st = nullptr;
    if (MK_N_LAUNCHES == 1) bar = xcd_barrier_post(ctl + CW_BAR, MISC + 8);
    const int lo = args.ph_lo, hi = args.ph_hi;
#ifndef PH_MASK
#define PH_MASK 0xFFFFFFFFu
#endif
#define IN(k) (lo <= (k) && (k) < hi && ((PH_MASK >> ((k) > 12 ? (k) - 7 : (k))) & 1u))
#define SEAM(k) do { if (IN(k) && IN((k) + 1)) xcd_barrier(bar); } while (0)

    if (IN(0)) {
        PH_BEGIN const float* x_in = INP(0); const float* w_in = INP(2); const float* b_in = INP(3); const float* w_out = INP(9); const float* pool_w = INP(11); const float* moe_w1 = INP(18); const float* moe_w2 = INP(20); bf16* WIN_T = WSP(bf16, WS_WIN); bf16* WOUT_T = WSP(bf16, WS_WOUT); bf16* PW_T = WSP(bf16, WS_PW); bf16* W1T = WSP(bf16, WS_W1); bf16* W2T = WSP(bf16, WS_W2); bf16* XB = WSP(bf16, WS_XB); float* DAB = WSP(float, WS_DAB);
        LAS float* scr = (LAS float*)(L + RING_OFF + wave * 16384);
        constexpr int I_IN = 16 * 88, I_OUT = 16 * 32, I_PW = 4 * 8, I_W1 = 16 * 64, I_W2 = 16 * 32;
        constexpr int S1 = I_IN, S2 = S1 + I_OUT, S3 = S2 + 4 * I_PW, S4 = S3 + 64 * I_W1, S5 = S4 + 64 * I_W2;
        for (int it = gw; it < S5; it += NGW) {
            if (it < S1) p0_transpose_item(w_in, 1024, INW, 88, WIN_T, scr, it, lane);
            else if (it < S2) p0_transpose_item(w_out, 1024, 1024, 32, WOUT_T, scr, it - S1, lane);
            else if (it < S3) { const int r = it - S2, g = r / I_PW; p0_transpose_item(pool_w + (size_t)g * 65536, 256, 256, 8, PW_T + (size_t)g * 65536, scr, r % I_PW, lane); }
            else if (it < S4) { const int r = it - S3, mt = r / I_W1; p0_transpose_item(moe_w1 + (size_t)mt * 2097152, 1024, 2048, 64, W1T + (size_t)mt * 2097152, scr, r % I_W1, lane); }
            else { const int r = it - S4, mt = r / I_W2; p0_transpose_item(moe_w2 + (size_t)mt * 1048576, 1024, 1024, 32, W2T + (size_t)mt * 1048576, scr, r % I_W2, lane); }
        }
        for (int m = gw; m < M; m += NGW) {
            const GAS f32x4* xr = (const GAS f32x4*)(x_in + (size_t)m * D) + lane;
            GAS v2u* o8 = (GAS v2u*)(XB + (size_t)m * D) + lane;
            float acc8[8];
#pragma unroll
            for (int q = 0; q < 8; ++q) acc8[q] = 0.f;
#pragma unroll
            for (int j = 0; j < 4; ++j) { const f32x4 v = xr[64 * j]; v2u w; w.x = pk2(v.x, v.y); w.y = pk2(v.z, v.w); o8[64 * j] = w;
#pragma unroll
                for (int c = 0; c < 4; ++c) { const int col = 256 * j + 4 * lane + c; const float xv = v[c];
                    const f32x4 wa = *(const GAS f32x4*)(w_in + (size_t)col * INW + INW_G), wb = *(const GAS f32x4*)(w_in + (size_t)col * INW + INW_G + 4);
                    acc8[0] += xv * wa.x; acc8[1] += xv * wa.y; acc8[2] += xv * wa.z; acc8[3] += xv * wa.w;
                    acc8[4] += xv * wb.x; acc8[5] += xv * wb.y; acc8[6] += xv * wb.z; acc8[7] += xv * wb.w; } }
#pragma unroll
            for (int q = 0; q < 8; ++q) acc8[q] = wave_sum(acc8[q]);
            if (lane < 8) { float r = 0.f;
#pragma unroll
                for (int q = 0; q < 8; ++q) r = (lane == q) ? acc8[q] : r;
                DAB[(size_t)m * 8 + lane] = r + b_in[INW_G + lane]; }
        }
    }
    SEAM(0);
    if (IN(1)) {
        PH_BEGIN const float* b_in = INP(3); bf16* WIN_T = WSP(bf16, WS_WIN); bf16* XB = WSP(bf16, WS_XB); float* PROJ = WSP(float, WS_PROJ);
        pg8::Gemm g{XB, WIN_T, 1024, 1024, 1024}; pg8::StaticOrder S; S.init(M, INW_G, G, blk);
        pg8::EpiF32 E{PROJ, INW_G, b_in, nullptr};
        pg8::gemm_phase<pg8::EpiF32, pg8::StaticOrder>(L + RING_OFF, g, S, E);
    }
    SEAM(1);
    if (IN(2)) {
        PH_BEGIN const int* positions = (const int*)INP(1); const float* conv_w = INP(4); const float* a_log = INP(5); const float* dt_bias = INP(6); float* PROJ = WSP(float, WS_PROJ); float* QN = WSP(float, WS_QN); float* KN = WSP(float, WS_KN); float* VV = WSP(float, WS_VV); float* DAB = WSP(float, WS_DAB); float* GG = WSP(float, WS_G); float* BETA = WSP(float, WS_BETA);
        for (int m = gw; m < M; m += NGW) {
            const float pos = (float)positions[m];
            float* row = PROJ + (size_t)m * INW_G;
#pragma unroll
            for (int it = 0; it < 2; ++it) { const int pi = lane + 64 * it;
                if (pi < 80) { const int hh = pi >> 3, i = pi & 7; const int col = (hh < 8 ? hh * 64 : C_K + (hh - 8) * 64) + i;
                    const float invf = (float)exp(-(double)i * (13.122363377404328 / 8.0));
                    const float ang = pos * invf; const float cs = cosf(ang), sn = sinf(ang);
                    const float x1 = row[col], x2 = row[col + 8];
                    row[col] = x1 * cs - x2 * sn; row[col + 8] = x2 * cs + x1 * sn; } }
        }
        for (int it = gw; it < M * 4; it += NGW) {
            const int m = it >> 2, h = it & 3, tt = m & (SEQ - 1);
            float ss[3];
            float vals[3][2];
#pragma unroll
            for (int c = 0; c < 3; ++c) {
                const int ch = c * 512 + h * 128 + lane * 2;
                float a0 = 0.f, a1 = 0.f;
#pragma unroll
                for (int j = 0; j < 4; ++j) { const int dt = 3 - j; if (tt - dt >= 0) { const float* pr = PROJ + (size_t)(m - dt) * INW_G + C_DQKV + ch;
                        a0 += conv_w[j * 1536 + ch] * pr[0]; a1 += conv_w[j * 1536 + ch + 1] * pr[1]; } }
                a0 = siluf_(a0); a1 = siluf_(a1);
                vals[c][0] = a0; vals[c][1] = a1; ss[c] = wave_sum(a0 * a0 + a1 * a1);
            }
            const float rq = rsqrtf(ss[0] + RMS_EPS) * 0.08838834764831845f, rk = rsqrtf(ss[1] + RMS_EPS);
            const size_t o = ((size_t)m * 4 + h) * 128 + lane * 2;
            QN[o] = vals[0][0] * rq; QN[o + 1] = vals[0][1] * rq; KN[o] = vals[1][0] * rk; KN[o + 1] = vals[1][1] * rk; VV[o] = vals[2][0]; VV[o + 1] = vals[2][1];
            if (lane == 0) { const float da = DAB[(size_t)m * 8 + h], db = DAB[(size_t)m * 8 + 4 + h];
                const float xx = da + dt_bias[h]; const float sp = xx > 20.f ? xx : log1pf(expf(xx));
                GG[(size_t)m * 4 + h] = -expf(a_log[h]) * sp; BETA[(size_t)m * 4 + h] = sigmoidf_(db); }
        }
    }
    SEAM(2);
    if (IN(3)) {
        PH_BEGIN const float* sinks = INP(8); float* PROJ = WSP(float, WS_PROJ); float* QN = WSP(float, WS_QN); float* KN = WSP(float, WS_KN); float* VV = WSP(float, WS_VV); float* GG = WSP(float, WS_G); float* BETA = WSP(float, WS_BETA); float* OO = WSP(float, WS_OO); bf16* MIX = WSP(bf16, WS_MIX);
        if (blk < 32 && G > 32) {
            const int b = blk >> 2, h = blk & 3, j = tid >> 2, p = tid & 3;
            LAS float* qL = (LAS float*)(L); LAS float* kL = qL + 16 * 128; LAS float* vL = kL + 16 * 128; LAS float* gL = vL + 16 * 128; LAS float* bL = gL + 16;
            float S[32];
#pragma unroll
            for (int i = 0; i < 32; ++i) S[i] = 0.f;
            const size_t row0 = (size_t)b * SEQ;
            for (int t0 = 0; t0 < SEQ; t0 += 16) {
                __syncthreads();
                for (int idx = tid; idx < 3 * 512; idx += 512) { const int which = idx >> 9, r = idx & 511, st = r >> 5, c4 = r & 31;
                    const float* src = (which == 0 ? QN : which == 1 ? KN : VV) + ((row0 + t0 + st) * 4 + h) * 128 + c4 * 4;
                    *(LAS f32x4*)((which == 0 ? qL : which == 1 ? kL : vL) + st * 128 + c4 * 4) = *(const GAS f32x4*)src; }
                if (tid < 16) { gL[tid] = GG[(row0 + t0 + tid) * 4 + h]; bL[tid] = BETA[(row0 + t0 + tid) * 4 + h]; }
                __syncthreads();
                for (int s = 0; s < 16; ++s) {
                    const float alpha = expf(gL[s]), beta = bL[s];
                    float kk[32], qq[32];
#pragma unroll
                    for (int i = 0; i < 8; ++i) { const f32x4 a = *(const LAS f32x4*)(kL + s * 128 + p * 32 + 4 * i), c = *(const LAS f32x4*)(qL + s * 128 + p * 32 + 4 * i);
                        kk[4 * i] = a.x; kk[4 * i + 1] = a.y; kk[4 * i + 2] = a.z; kk[4 * i + 3] = a.w; qq[4 * i] = c.x; qq[4 * i + 1] = c.y; qq[4 * i + 2] = c.z; qq[4 * i + 3] = c.w; }
                    float ks = 0.f;
#pragma unroll
                    for (int i = 0; i < 32; ++i) ks += kk[i] * S[i];
                    ks += __shfl_xor(ks, 1); ks += __shfl_xor(ks, 2);
                    const float coef = beta * (vL[s * 128 + j] - alpha * ks);
                    float os = 0.f;
#pragma unroll
                    for (int i = 0; i < 32; ++i) { S[i] = alpha * S[i] + kk[i] * coef; os += qq[i] * S[i]; }
                    os += __shfl_xor(os, 1); os += __shfl_xor(os, 2);
                    if (p == 0) OO[((row0 + t0 + s) * 4 + h) * 128 + j] = os;
                }
            }
        } else {
            const int nw = (G > 32) ? (G - 32) * NWAVES : NGW, w0 = (G > 32) ? gw - 32 * NWAVES : gw;
            for (int it = w0; it < M * 8; it += nw) {
                const int m = it >> 3, hq = it & 7, tt = m & (SEQ - 1), kvh = hq >> 2;
                const float* qp = PROJ + (size_t)m * INW_G + C_Q + hq * 64;
                float qv[64];
#pragma unroll
                for (int i = 0; i < 16; ++i) { const f32x4 a = *(const GAS f32x4*)(qp + 4 * i); qv[4 * i] = a.x; qv[4 * i + 1] = a.y; qv[4 * i + 2] = a.z; qv[4 * i + 3] = a.w; }
                float sc[2];
#pragma unroll
                for (int hh = 0; hh < 2; ++hh) { const int dj = hh * 64 + lane; float s = -INFINITY;
                    if (tt - dj >= 0) { const float* kp = PROJ + (size_t)(m - dj) * INW_G + C_K + kvh * 64; float a = 0.f;
#pragma unroll
                        for (int i = 0; i < 16; ++i) { const f32x4 kq = *(const GAS f32x4*)(kp + 4 * i); a += qv[4 * i] * kq.x + qv[4 * i + 1] * kq.y + qv[4 * i + 2] * kq.z + qv[4 * i + 3] * kq.w; }
                        s = a * 0.125f; }
                    sc[hh] = s; }
                const float sink = sinks[hq];
                const float mx = fmaxf(wave_max(fmaxf(sc[0], sc[1])), sink);
                const float p0 = (sc[0] == -INFINITY) ? 0.f : expf(sc[0] - mx), p1 = (sc[1] == -INFINITY) ? 0.f : expf(sc[1] - mx);
                const float den = wave_sum(p0 + p1) + expf(sink - mx);
                float acc = 0.f;
                const int nk = tt + 1 < 128 ? tt + 1 : 128;
                const float* vp = PROJ + (size_t)m * INW_G + C_V + kvh * 64 + lane;
                for (int dj = 0; dj < nk; ++dj) { const float pj = __shfl(dj < 64 ? p0 : p1, dj & 63); acc += pj * vp[-(ptrdiff_t)dj * INW_G]; }
                MIX[(size_t)m * 1024 + hq * 64 + lane] = (bf16)f2bf(acc / den);
            }
        }
    }
    SEAM(3);
    if (IN(4)) {
        PH_BEGIN const float* norm_w = INP(7); float* PROJ = WSP(float, WS_PROJ); float* OO = WSP(float, WS_OO); bf16* MIX = WSP(bf16, WS_MIX);
        for (int it = gw; it < M * 4; it += NGW) {
            const int m = it >> 2, h = it & 3;
            const float* op = OO + ((size_t)m * 4 + h) * 128 + lane * 2;
            const float o0 = op[0], o1 = op[1];
            const float r = rsqrtf(wave_sum(o0 * o0 + o1 * o1) * (1.0f / 128.0f) + RMS_EPS);
            const float* zp = PROJ + (size_t)m * INW_G + C_DZ + h * 128 + lane * 2;
            const float y0 = o0 * r * norm_w[lane * 2] * siluf_(zp[0]), y1 = o1 * r * norm_w[lane * 2 + 1] * siluf_(zp[1]);
            *(unsigned*)(MIX + (size_t)m * 1024 + 512 + h * 128 + lane * 2) = pk2(y0, y1);
        }
    }
    SEAM(4);
    if (IN(5)) {
        PH_BEGIN const float* b_out = INP(10); bf16* WOUT_T = WSP(bf16, WS_WOUT); bf16* MIX = WSP(bf16, WS_MIX); float* H = WSP(float, WS_H);
        pg8::Gemm g{MIX, WOUT_T, 1024, 1024, 1024}; pg8::StaticOrder S; S.init(M, 1024, G, blk);
        pg8::EpiF32 E{H, 1024, b_out, nullptr};
        pg8::gemm_phase<pg8::EpiF32, pg8::StaticOrder>(L + RING_OFF, g, S, E);
    }
    SEAM(5);

    for (int layer = 0; layer < 2; ++layer) {
        const int pb = layer == 0 ? 6 : 13;
        if (layer == 1) {
            if (IN(11)) {
            PH_BEGIN float* X2 = WSP(float, WS_X2); bf16* POOLED = WSP(bf16, WS_POOLED);
                for (int m = gw; m < M; m += NGW) {
                    const int tt = m & (SEQ - 1);
#pragma unroll
                    for (int gi = 0; gi < 4; ++gi) { const int win = 2 << gi; const int cnt = tt + 1 < win ? tt + 1 : win;
                        const float* xp = X2 + (size_t)m * D + gi * 256 + lane * 4;
                        const f32x4 self = *(const GAS f32x4*)xp; f32x4 s = self;
                        for (int d = 1; d < cnt; ++d) s = s + *(const GAS f32x4*)(xp - (size_t)d * D);
                        const float ic = 1.0f / (float)cnt;
                        v2u w; w.x = pk2(s.x * ic - self.x, s.y * ic - self.y); w.y = pk2(s.z * ic - self.z, s.w * ic - self.w);
                        *(GAS v2u*)(POOLED + (size_t)m * D + gi * 256 + lane * 4) = w; }
                }
            }
            SEAM(11);
            if (IN(12)) {
            PH_BEGIN const float* pool_b = INP(12); const float* pool_scale = INP(13); bf16* POOLED = WSP(bf16, WS_POOLED); bf16* PW_T = WSP(bf16, WS_PW); float* H = WSP(float, WS_H);
                pg8::Gemm g{POOLED, PW_T, 256, 1024, 256}; pg8::PoolOrder S{G, blk};
                pg8::EpiF32 E{H, 1024, pool_b, pool_scale};
                pg8::gemm_phase<pg8::EpiF32, pg8::PoolOrder>(L + RING_OFF, g, S, E);
            }
            SEAM(12);
        }
        if (IN(pb)) {
            PH_BEGIN const float* x_in = INP(0); const float* ln1_g = INP(14); const float* ln1_b = INP(15); const float* router_w = INP(16); const float* router_b = INP(17); float* X2 = WSP(float, WS_X2); float* H = WSP(float, WS_H); float* X1 = WSP(float, WS_X1); bf16* XB = WSP(bf16, WS_XB); int* TOPI = WSP(int, WS_TOPI); float* TOPW = WSP(float, WS_TOPW); int* meta = WSP(int, WS_META);
            LAS int* hist = (LAS int*)(L); LAS float* yrow = (LAS float*)(L + 4096 + wave * 4096);
            if (tid < 32) hist[tid] = 0;
            __syncthreads();
            const float* xin = layer == 0 ? x_in : X2;
            const float* g1 = ln1_g + layer * D; const float* b1v = ln1_b + layer * D;
            const float* rw = router_w + (size_t)layer * D * NE; const float* rb = router_b + layer * NE;
            for (int it = 0; it < M / NGW; ++it) {
                const int m = it * NGW + gw;
                const GAS f32x4* xr = (const GAS f32x4*)(xin + (size_t)m * D) + lane; const GAS f32x4* hr = (const GAS f32x4*)(H + (size_t)m * D) + lane;
                f32x4 v[4]; float s = 0.f;
#pragma unroll
                for (int j = 0; j < 4; ++j) { v[j] = xr[64 * j] * ALPHA + hr[64 * j]; s += (v[j].x + v[j].y) + (v[j].z + v[j].w); }
                const float mean = wave_sum(s) * (1.f / D); float s2 = 0.f;
#pragma unroll
                for (int j = 0; j < 4; ++j) { v[j] = v[j] - mean; s2 += (v[j].x * v[j].x + v[j].y * v[j].y) + (v[j].z * v[j].z + v[j].w * v[j].w); }
                const float rstd = rsqrtf(wave_sum(s2) * (1.f / D) + LN_EPS);
#pragma unroll
                for (int j = 0; j < 4; ++j) { const int col = 256 * j + 4 * lane;
                    const f32x4 gv = *(const GAS f32x4*)(g1 + col), bv = *(const GAS f32x4*)(b1v + col);
                    v[j] = v[j] * rstd * gv + bv;
                    *((GAS f32x4*)(X1 + (size_t)m * D) + lane + 64 * j) = v[j];
                    v2u w; w.x = pk2(v[j].x, v[j].y); w.y = pk2(v[j].z, v[j].w); *((GAS v2u*)(XB + (size_t)m * D) + lane + 64 * j) = w;
                    *(LAS f32x4*)(yrow + col) = v[j]; }
                asm volatile("s_waitcnt lgkmcnt(0)" ::: "memory");
                float mine;
                { const int e = lane & 31, hh = lane >> 5; const float* rwp = rw + (size_t)(hh * 512) * NE + e; const LAS float* yp = yrow + hh * 512;
                    float a0 = 0.f, a1 = 0.f, a2 = 0.f, a3 = 0.f;
#pragma unroll 4
                    for (int c = 0; c < 512; c += 4) { const f32x4 yv = *(const LAS f32x4*)(yp + c);
                        a0 += yv.x * rwp[(size_t)c * NE]; a1 += yv.y * rwp[(size_t)(c + 1) * NE]; a2 += yv.z * rwp[(size_t)(c + 2) * NE]; a3 += yv.w * rwp[(size_t)(c + 3) * NE]; }
                    const float part = (a0 + a1) + (a2 + a3);
                    const float logit = part + __shfl_xor(part, 32) + rb[e];
                    mine = lane < 32 ? logit : -INFINITY; }
                asm volatile("s_waitcnt lgkmcnt(0)" ::: "memory");
                float tv[4]; int ti[4];
#pragma unroll
                for (int k = 0; k < 4; ++k) { float bv = mine; int bi = lane;
#pragma unroll
                    for (int o = 1; o < 64; o <<= 1) { const float ov = __shfl_xor(bv, o); const int oi = __shfl_xor(bi, o); if (ov > bv || (ov == bv && oi < bi)) { bv = ov; bi = oi; } }
                    tv[k] = bv; ti[k] = bi; if (lane == bi) mine = -INFINITY; }
                const float e1 = expf(tv[1] - tv[0]), e2 = expf(tv[2] - tv[0]), e3 = expf(tv[3] - tv[0]); const float inv = 1.0f / (1.0f + e1 + e2 + e3);
                if (lane < 4) { const int ix = lane == 0 ? ti[0] : lane == 1 ? ti[1] : lane == 2 ? ti[2] : ti[3]; const float wv = (lane == 0 ? 1.0f : lane == 1 ? e1 : lane == 2 ? e2 : e3) * inv;
                    TOPI[(size_t)m * 4 + lane] = ix; TOPW[(size_t)m * 4 + lane] = wv; atomicAdd((int*)(hist + ix), 1); }
            }
            __syncthreads();
            if (tid < 32) meta[META_BHIST + blk * 32 + tid] = hist[tid];
        }
        SEAM(pb);
        if (IN(pb + 1)) {
            PH_BEGIN bf16* XB = WSP(bf16, WS_XB); int* TOPI = WSP(int, WS_TOPI); int* TOKPOS = WSP(int, WS_TOKPOS); int* SORTED = WSP(int, WS_SORTED); bf16* XPERM = WSP(bf16, WS_XPERM); int* meta = WSP(int, WS_META);
            LAS int* hl = (LAS int*)(L); LAS int* cntL = hl + 8192; LAS int* mineL = cntL + 32; LAS int* baseL = mineL + 32; LAS int* entL = baseL + 40; LAS int* posL = entL + 256;
            for (int i = tid; i < G * 32; i += 512) hl[i] = meta[META_BHIST + i];
            if (tid < 256) { const int it = tid >> 5, w = (tid >> 2) & 7, k = tid & 3; const int m = it * NGW + blk * NWAVES + w; entL[tid] = TOPI[(size_t)m * 4 + k]; }
            __syncthreads();
            if (tid < 32) { int cnt = 0, mine = 0; for (int b = 0; b < G; ++b) { const int c = hl[b * 32 + tid]; if (b < blk) mine += c; cnt += c; } cntL[tid] = cnt; mineL[tid] = mine; }
            __syncthreads();
            if (tid == 0) { int base = 0; for (int e = 0; e < 32; ++e) { baseL[e] = base; base += (cntL[e] + 255) & ~255; } baseL[32] = base; }
            __syncthreads();
            if (tid < 32) { int off = baseL[tid] + mineL[tid]; for (int ent = 0; ent < 256; ++ent) if (entL[ent] == tid) posL[ent] = off++; }
            __syncthreads();
            if (tid < 256) { const int it = tid >> 5, w = (tid >> 2) & 7, k = tid & 3; const int m = it * NGW + blk * NWAVES + w; const int pos = posL[tid]; TOKPOS[(size_t)m * 4 + k] = pos; SORTED[pos] = m; }
            for (int en = wave * 32; en < wave * 32 + 32; ++en) { const int it = en >> 5, w = (en >> 2) & 7; const int m = it * NGW + blk * NWAVES + w; const int pos = posL[en];
                const GAS v4u* src = (const GAS v4u*)(XB + (size_t)m * D); GAS v4u* dst = (GAS v4u*)(XPERM + (size_t)pos * D);
                dst[lane] = src[lane]; dst[lane + 64] = src[lane + 64]; }
            if (blk < 32) { const int e = blk; const int r0 = baseL[e] + cntL[e], r1 = baseL[e + 1];
                for (int r = r0 + wave; r < r1; r += NWAVES) { GAS v4u* dst = (GAS v4u*)(XPERM + (size_t)r * D); const v4u z = {0u, 0u, 0u, 0u}; dst[lane] = z; dst[lane + 64] = z; if (lane == 0) SORTED[r] = -1; } }
            if (blk == 0) { if (tid < 32) { for (int pm = baseL[tid] >> 8; pm < (baseL[tid + 1] >> 8); ++pm) meta[META_TILE_E + pm] = tid; } if (tid == 0) meta[META_NTILES] = baseL[32] >> 8; }
        }
        SEAM(pb + 1);
        if (IN(pb + 2)) {
            PH_BEGIN const float* moe_b1 = INP(19); bf16* W1T = WSP(bf16, WS_W1); bf16* XPERM = WSP(bf16, WS_XPERM); bf16* ACT = WSP(bf16, WS_ACT); int* meta = WSP(int, WS_META);
            pg8::Gemm g{XPERM, W1T + (size_t)layer * NE * 2048 * 1024, 1024, 1024, 1024};
            pg8::GroupedOrder S{meta + META_TILE_E, meta[META_NTILES], 8, G, blk};
            pg8::EpiSwiGLU E{ACT, moe_b1 + (size_t)layer * NE * 2048};
            pg8::gemm_phase<pg8::EpiSwiGLU, pg8::GroupedOrder>(L + RING_OFF, g, S, E);
        }
        SEAM(pb + 2);
        if (IN(pb + 3)) {
            PH_BEGIN const float* moe_b2 = INP(21); bf16* W2T = WSP(bf16, WS_W2); bf16* ACT = WSP(bf16, WS_ACT); float* YS = WSP(float, WS_YS); int* meta = WSP(int, WS_META);
            pg8::Gemm g{ACT, W2T + (size_t)layer * NE * 1024 * 1024, 1024, 1024, 1024};
            pg8::GroupedOrder S{meta + META_TILE_E, meta[META_NTILES], 4, G, blk};
            pg8::EpiYS E{YS, moe_b2 + (size_t)layer * NE * 1024};
            pg8::gemm_phase<pg8::EpiYS, pg8::GroupedOrder>(L + RING_OFF, g, S, E);
        }
        SEAM(pb + 3);
        if (IN(pb + 4)) {
            PH_BEGIN const float* ln2_g = INP(22); const float* ln2_b = INP(23); float* X1 = WSP(float, WS_X1); float* X2 = WSP(float, WS_X2); float* YS = WSP(float, WS_YS); int* TOKPOS = WSP(int, WS_TOKPOS); float* TOPW = WSP(float, WS_TOPW); float* xout = layer == 0 ? X2 : A_->out;
            const float* g2 = ln2_g + layer * D; const float* b2v = ln2_b + layer * D;
            for (int m = gw; m < M; m += NGW) {
                f32x4 v[4];
                const GAS f32x4* xr = (const GAS f32x4*)(X1 + (size_t)m * D) + lane;
#pragma unroll
                for (int j = 0; j < 4; ++j) v[j] = xr[64 * j] * ALPHA;
#pragma unroll
                for (int k = 0; k < 4; ++k) { const int pos = TOKPOS[(size_t)m * 4 + k]; const float wv = TOPW[(size_t)m * 4 + k];
                    const GAS f32x4* yr = (const GAS f32x4*)(YS + (size_t)pos * D) + lane;
#pragma unroll
                    for (int j = 0; j < 4; ++j) v[j] = v[j] + yr[64 * j] * wv; }
                float s = 0.f;
#pragma unroll
                for (int j = 0; j < 4; ++j) s += (v[j].x + v[j].y) + (v[j].z + v[j].w);
                const float mean = wave_sum(s) * (1.f / D); float s2 = 0.f;
#pragma unroll
                for (int j = 0; j < 4; ++j) { v[j] = v[j] - mean; s2 += (v[j].x * v[j].x + v[j].y * v[j].y) + (v[j].z * v[j].z + v[j].w * v[j].w); }
                const float rstd = rsqrtf(wave_sum(s2) * (1.f / D) + LN_EPS);
#pragma unroll
                for (int j = 0; j < 4; ++j) { const int col = 256 * j + 4 * lane; const f32x4 gv = *(const GAS f32x4*)(g2 + col), bv = *(const GAS f32x4*)(b2v + col);
                    *((GAS f32x4*)(xout + (size_t)m * D) + lane + 64 * j) = v[j] * rstd * gv + bv; }
            }
        }
        if (layer == 0) SEAM(pb + 4);
    }
#undef IN
#undef SEAM
}

constexpr int N_PHASES = 18;
extern "C" void kernel_launch(void* const* d_in, const int* in_sizes, int n_in, void* d_out, int out_size, void* d_ws, size_t ws_size, hipStream_t stream) {
    static int grid = 0;
    if (grid == 0) {
        if (n_in != 24 || out_size != M * D || ws_size < WS_END) { fprintf(stderr, "kernel_launch: unexpected shapes (n_in %d, out %d, ws %zu < %zu); nothing launched\n", n_in, out_size, ws_size, (size_t)WS_END); grid = -1; return; }
        int dev = 0, cus = 0, per_cu = 0;
        if (hipGetDevice(&dev) != hipSuccess || hipDeviceGetAttribute(&cus, hipDeviceAttributeMultiprocessorCount, dev) != hipSuccess) { grid = -1; return; }
        if (hipFuncSetAttribute((const void*)hybrid_fwd, hipFuncAttributeMaxDynamicSharedMemorySize, LDS_BYTES) != hipSuccess) { fprintf(stderr, "kernel_launch: hipFuncSetAttribute failed\n"); grid = -1; return; }
        if (hipOccupancyMaxActiveBlocksPerMultiprocessor(&per_cu, (const void*)hybrid_fwd, NWAVES * 64, LDS_BYTES) != hipSuccess || per_cu < 1) { fprintf(stderr, "kernel_launch: occupancy query says %d\n", per_cu); (void)hipGetLastError(); grid = -1; return; }
        if (cus != 256) { fprintf(stderr, "kernel_launch: built for a 256-CU device, found %d\n", cus); grid = -1; return; }
        grid = cus;
    }
    if (grid < 0) return;
    (void)hipMemsetAsync((char*)d_ws + WS_CTL, 0, CTL_ZERO_BYTES, stream);
    Args a{};
    for (int i = 0; i < 24; ++i) a.in[i] = (const float*)d_in[i];
    a.out = (float*)d_out; a.ws = (unsigned char*)d_ws;
#if MK_N_LAUNCHES == 1
    a.ph_lo = 0; a.ph_hi = N_PHASES;
    hipLaunchKernelGGL(hybrid_fwd, dim3(grid), dim3(NWAVES * 64), LDS_BYTES, stream, a);
#else
    for (int p = 0; p < N_PHASES; ++p) { a.ph_lo = p; a.ph_hi = p + 1; hipLaunchKernelGGL(hybrid_fwd, dim3(grid), dim3(NWAVES * 64), LDS_BYTES, stream, a); }
#endif
}
```

```cpp
#include <hip/hip_runtime.h>
#include <cstdio>
#include <cstdint>

#ifndef MK_N_LAUNCHES
#define MK_N_LAUNCHES 1
#endif

namespace pg8 {
#define PG8_LAS __attribute__((address_space(3)))
typedef unsigned short bf16_t;
typedef short bf16x8 __attribute__((ext_vector_type(8)));
typedef float f32x4 __attribute__((ext_vector_type(4)));
typedef unsigned u32x4 __attribute__((ext_vector_type(4)));
typedef unsigned u32x2 __attribute__((ext_vector_type(2)));
constexpr int BM = 256, BK = 64, HALF = 128, HTB = HALF * BK * 2  , STAGE_BYTES = 8 * HTB, NXCD = 8, WGM = 8;

__host__ __device__ __forceinline__ int lds_byte(int r, int c) { const int st = (r >> 4) * 2 + (c >> 5), rr = r & 15, cc = c & 31, ob = rr * 64 + cc * 2; return st * 1024 + (ob ^ (((ob >> 9) & 1) << 5)); }
__host__ __device__ __forceinline__ void stage_rc(int b, int& R, int& C) { const int st = b / 1024, sb = b % 1024, swz = sb ^ (((sb >> 9) & 1) << 5); R = (st >> 1) * 16 + swz / 64; C = (st & 1) * 32 + (swz % 64) / 2; }
__host__ __device__ __forceinline__ int perm32(int rho) { const int n = rho >> 4, i = rho & 15; return 8 * (i >> 2) + 4 * n + (i & 3); }

struct Unit { int pm, pn, aoff; };
struct Gemm { const bf16_t* A; const bf16_t* Bt; int K, lda, ldb; };

struct StaticOrder {
    int nM, nN, nwg, G, c;
    __host__ __device__ void init(int M, int N, int G_, int c_) { nM = M / BM; nN = N / BM; nwg = nM * nN; G = G_; c = c_; }
    __host__ __device__ bool next(int i, Unit& u) const {
        const long L = (long)i * G + c; if (L >= nwg) return false;
        int wgid = (int)L; { const int q = nwg / NXCD, r = nwg % NXCD, xcd = wgid % NXCD, off = wgid / NXCD; wgid = (xcd < r ? xcd * (q + 1) : r * (q + 1) + (xcd - r) * q) + off; }
        const int nig = WGM * nN, gid = wgid / nig, fm = gid * WGM, gsz = (nM - fm) < WGM ? (nM - fm) : WGM;
        u.pm = fm + ((wgid % nig) % gsz); u.pn = (wgid % nig) / gsz; u.aoff = 0; return true;
    }
};
struct PoolOrder {
    int G, c;
    __device__ bool next(int i, Unit& u) const { const int L = i * G + c; if (L >= 256) return false; u.pm = L >> 2; u.pn = L & 3; u.aoff = (L & 3) * 256 * 2; return true; }
};
struct GroupedOrder {
    const int* tile_e; int ntiles, nN, G, c;
    __device__ bool next(int i, Unit& u) const {
        int pm, pnl;
        if (G == 256) { const int x = c & 7, j = c >> 3, s = i * 8 + x; if (nN == 8) { pm = 4 * s + (j >> 3); pnl = j & 7; } else { pm = 8 * s + (j >> 2); pnl = j & 3; } }
        else { const int L = i * G + c; pm = L / nN; pnl = L % nN; }
        if (pm >= ntiles) return false;
        const int e = tile_e[pm]; u.pm = pm; u.pn = e * nN + pnl; u.aoff = 0; return true;
    }
};

__device__ __forceinline__ unsigned cvt_pk_bf16(float lo, float hi) { unsigned r; asm volatile("v_cvt_pk_bf16_f32 %0, %1, %2" : "=v"(r) : "v"(lo), "v"(hi)); return r; }

struct EpiF32 {
    static constexpr bool PERM = false;
    float* C; int ldc; const float* bias; const float* scale;
    __device__ __forceinline__ void operator()(const f32x4 (&acc)[2][2][4][2], const Unit& u, int wr, int wc, int fr, int fq) const {
        const int row0 = u.pm * BM + wr * 64 + fr, col0 = u.pn * BM + wc * 32 + 4 * fq;
        f32x4 bv[2][2], sv[2][2];
#pragma unroll
        for (int bj = 0; bj < 2; ++bj)
#pragma unroll
            for (int n = 0; n < 2; ++n) { bv[bj][n] = bias ? *(const f32x4*)(bias + col0 + bj * HALF + n * 16) : (f32x4){0.f, 0.f, 0.f, 0.f};
                                          sv[bj][n] = scale ? *(const f32x4*)(scale + col0 + bj * HALF + n * 16) : (f32x4){1.f, 1.f, 1.f, 1.f}; }
#pragma unroll
        for (int ai = 0; ai < 2; ++ai)
#pragma unroll
            for (int m = 0; m < 4; ++m) { float* rowp = C + (size_t)(row0 + ai * HALF + m * 16) * ldc + col0;
#pragma unroll
                for (int bj = 0; bj < 2; ++bj)
#pragma unroll
                    for (int n = 0; n < 2; ++n) *(f32x4*)(rowp + bj * HALF + n * 16) = (acc[ai][bj][m][n] + bv[bj][n]) * sv[bj][n]; }
    }
};
struct EpiYS {
    static constexpr bool PERM = false;
    float* C; const float* b2;
    __device__ __forceinline__ void operator()(const f32x4 (&acc)[2][2][4][2], const Unit& u, int wr, int wc, int fr, int fq) const {
        const int e = u.pn >> 2, pnl = u.pn & 3;
        const int row0 = u.pm * BM + wr * 64 + fr, col0 = pnl * BM + wc * 32 + 4 * fq;
        const float* bias = b2 + e * 1024;
        f32x4 bv[2][2];
#pragma unroll
        for (int bj = 0; bj < 2; ++bj)
#pragma unroll
            for (int n = 0; n < 2; ++n) bv[bj][n] = *(const f32x4*)(bias + col0 + bj * HALF + n * 16);
#pragma unroll
        for (int ai = 0; ai < 2; ++ai)
#pragma unroll
            for (int m = 0; m < 4; ++m) { float* rowp = C + (size_t)(row0 + ai * HALF + m * 16) * 1024 + col0;
#pragma unroll
                for (int bj = 0; bj < 2; ++bj)
#pragma unroll
                    for (int n = 0; n < 2; ++n) *(f32x4*)(rowp + bj * HALF + n * 16) = acc[ai][bj][m][n] + bv[bj][n]; }
    }
};
struct EpiSwiGLU {
    static constexpr bool PERM = true;
    bf16_t* O; const float* b1;
    __device__ __forceinline__ void operator()(const f32x4 (&acc)[2][2][4][2], const Unit& u, int wr, int wc, int fr, int fq) const {
        const int e = u.pn >> 3, pnl = u.pn & 7;
        const int row0 = u.pm * BM + wr * 64 + fr, col0 = pnl * BM + wc * 32 + 8 * fq;
        const float* bias = b1 + e * 2048;
        f32x4 bv[2][2];
#pragma unroll
        for (int bj = 0; bj < 2; ++bj)
#pragma unroll
            for (int n = 0; n < 2; ++n) bv[bj][n] = *(const f32x4*)(bias + col0 + bj * HALF + 4 * n);
#pragma unroll
        for (int ai = 0; ai < 2; ++ai)
#pragma unroll
            for (int m = 0; m < 4; ++m) { bf16_t* rowp = O + (size_t)(row0 + ai * HALF + m * 16) * 1024 + (col0 >> 1);
#pragma unroll
                for (int bj = 0; bj < 2; ++bj) { const f32x4 v0 = acc[ai][bj][m][0] + bv[bj][0], v1 = acc[ai][bj][m][1] + bv[bj][1];
                    float g[4] = {v0[0], v0[2], v1[0], v1[2]}, l[4] = {v0[1], v0[3], v1[1], v1[3]}, a[4];
#pragma unroll
                    for (int q = 0; q < 4; ++q) { const float hg = fminf(g[q], 7.0f), hl = fminf(fmaxf(l[q], -7.0f), 7.0f);
                        a[q] = hg * (1.0f / (1.0f + __expf(-1.702f * hg))) * (hl + 1.0f); }
                    u32x2 w; w.x = cvt_pk_bf16(a[0], a[1]); w.y = cvt_pk_bf16(a[2], a[3]);
                    *(u32x2*)(rowp + bj * (HALF / 2)) = w; } }
    }
};

template <class Epi, class Sched>
__device__ __forceinline__ void gemm_phase(PG8_LAS unsigned char* lds, const Gemm g, const Sched& S, const Epi& E) {
    int tid = threadIdx.x; asm volatile("" : "+v"(tid));
    const int wid = __builtin_amdgcn_readfirstlane(tid >> 6), lane = tid & 63, wr = wid >> 2, wc = wid & 3, fr = lane & 15, fq = lane >> 4;
    int K = g.K; asm volatile("" : "+s"(K)); const int nt = K / BK;
    unsigned voffA[2], voffB[2];
#pragma unroll
    for (int i = 0; i < 2; ++i) { int R, C; stage_rc(tid * 16 + i * 8192, R, C); const int Rb = Epi::PERM ? ((R & ~31) + perm32(R & 31)) : R;
        voffA[i] = (unsigned)(R * g.lda + C) * 2u; voffB[i] = (unsigned)(Rb * g.ldb + C) * 2u; }
    const size_t kstep = (size_t)(BK * 2);
    const size_t hstepA = (size_t)HALF * g.lda * 2, hstepB = (size_t)HALF * g.ldb * 2;
    const size_t tstepA = 2 * hstepA, tstepB = 2 * hstepB;
    const unsigned ldsw = (unsigned)wid * 1024u;
    const int aoff = lds_byte(wr * 64 + fr, fq * 8), boff = lds_byte(wc * 32 + fr, fq * 8);
#define PG8_SA(b, h) (((b) * 2 + (h)) * HTB)
#define PG8_SB(b, h) ((4 + (b) * 2 + (h)) * HTB)
#define PG8_STAGE(bufoff, gbase, voff) do { _Pragma("unroll") for (int _i = 0; _i < 2; ++_i) \
        __builtin_amdgcn_global_load_lds((const unsigned*)((const char*)(gbase) + (voff)[_i]), (PG8_LAS unsigned*)(lds + (bufoff) + ldsw + _i * 8192), 16, 0, 0); } while (0)
#define PG8_LDA(dst, b, h) do { _Pragma("unroll") for (int m = 0; m < 4; ++m) _Pragma("unroll") for (int k = 0; k < 2; ++k) dst[m][k] = *(const PG8_LAS bf16x8*)(lds + PG8_SA(b, h) + aoff + m * 2048 + k * 1024); } while (0)
#define PG8_LDB(dst, b, h) do { _Pragma("unroll") for (int n = 0; n < 2; ++n) _Pragma("unroll") for (int k = 0; k < 2; ++k) dst[n][k] = *(const PG8_LAS bf16x8*)(lds + PG8_SB(b, h) + boff + n * 2048 + k * 1024); } while (0)
#define PG8_MMA(ai, bj, At, Bt) do { __builtin_amdgcn_s_setprio(1); _Pragma("unroll") for (int m = 0; m < 4; ++m) _Pragma("unroll") for (int n = 0; n < 2; ++n) _Pragma("unroll") for (int k = 0; k < 2; ++k) \
        acc[ai][bj][m][n] = __builtin_amdgcn_mfma_f32_16x16x32_bf16(Bt[n][k], At[m][k], acc[ai][bj][m][n], 0, 0, 0); __builtin_amdgcn_s_setprio(0); } while (0)
#define PG8_WAIT_V(n) asm volatile("s_waitcnt vmcnt(" #n ")" ::: "memory")
#define PG8_WAIT_L(n) asm volatile("s_waitcnt lgkmcnt(" #n ")" ::: "memory")
#define PG8_BAR __builtin_amdgcn_s_barrier()
#define PG8_SCHED __builtin_amdgcn_sched_barrier(0)
    Unit cur, nxt; int ui = 0;
    if (!S.next(0, cur)) return;
    f32x4 acc[2][2][4][2];
#pragma unroll
    for (int a = 0; a < 2; ++a)
#pragma unroll
        for (int b = 0; b < 2; ++b)
#pragma unroll
            for (int m = 0; m < 4; ++m)
#pragma unroll
                for (int n = 0; n < 2; ++n) acc[a][b][m][n] = (f32x4){0.f, 0.f, 0.f, 0.f};
    bf16x8 At[4][2], B0[2][2], B1[2][2];
    const char* cA = (const char*)g.A + (size_t)cur.pm * tstepA + cur.aoff; const char* cB = (const char*)g.Bt + (size_t)cur.pn * tstepB;
    PG8_STAGE(PG8_SB(0, 0), cB, voffB); PG8_STAGE(PG8_SB(0, 1), cB + hstepB, voffB); PG8_STAGE(PG8_SA(0, 0), cA, voffA); PG8_STAGE(PG8_SA(0, 1), cA + hstepA, voffA);
    if (wr == 1) PG8_BAR;
    PG8_WAIT_V(2); PG8_BAR;
    PG8_STAGE(PG8_SB(1, 0), cB + kstep, voffB); PG8_STAGE(PG8_SA(1, 0), cA + kstep, voffA); PG8_STAGE(PG8_SB(1, 1), cB + hstepB + kstep, voffB);
    PG8_WAIT_V(6); PG8_BAR;
    for (;;) {
        const bool has_next = S.next(ui + 1, nxt);
        const char* nA = has_next ? (const char*)g.A + (size_t)nxt.pm * tstepA + nxt.aoff : cA; const char* nB = has_next ? (const char*)g.Bt + (size_t)nxt.pn * tstepB : cB;
        for (int t = 0; t < nt; t += 2) {
            const bool last = (t == nt - 2);
            const char* a1 = cA + (size_t)(t + 1) * kstep;
            const char* a2 = last ? nA : cA + (size_t)(t + 2) * kstep; const char* b2 = last ? nB : cB + (size_t)(t + 2) * kstep;
            const char* a3 = a2 + kstep; const char* b3 = b2 + kstep;
            PG8_LDB(B0, 0, 0); PG8_LDB(B1, 0, 1); PG8_SCHED; PG8_LDA(At, 0, 0); PG8_STAGE(PG8_SA(1, 1), a1 + hstepA, voffA);
            PG8_WAIT_V(8); PG8_WAIT_L(0); PG8_BAR; PG8_MMA(0, 0, At, B0); PG8_MMA(0, 1, At, B1); PG8_BAR; PG8_SCHED;
            PG8_LDA(At, 0, 1); PG8_STAGE(PG8_SB(0, 0), b2, voffB); PG8_STAGE(PG8_SB(0, 1), b2 + hstepB, voffB); PG8_STAGE(PG8_SA(0, 0), a2, voffA);
            PG8_WAIT_V(8); PG8_WAIT_L(0); PG8_BAR; PG8_MMA(1, 0, At, B0); PG8_MMA(1, 1, At, B1); PG8_BAR; PG8_SCHED;
            PG8_LDB(B0, 1, 0); PG8_LDB(B1, 1, 1); PG8_SCHED; PG8_LDA(At, 1, 0); PG8_STAGE(PG8_SA(0, 1), a2 + hstepA, voffA);
            PG8_WAIT_V(8); PG8_WAIT_L(0); PG8_BAR; PG8_MMA(0, 0, At, B0); PG8_MMA(0, 1, At, B1); PG8_BAR; PG8_SCHED;
            PG8_LDA(At, 1, 1); PG8_STAGE(PG8_SB(1, 0), b3, voffB); PG8_STAGE(PG8_SB(1, 1), b3 + hstepB, voffB); PG8_STAGE(PG8_SA(1, 0), a3, voffA);
            PG8_WAIT_V(8); PG8_WAIT_L(0); PG8_BAR; PG8_MMA(1, 0, At, B0); PG8_MMA(1, 1, At, B1); PG8_BAR; PG8_SCHED;
        }
        if (wr == 0) PG8_BAR;
        E(acc, cur, wr, wc, fr, fq);
        if (!has_next) break;
#pragma unroll
        for (int a = 0; a < 2; ++a)
#pragma unroll
            for (int b = 0; b < 2; ++b)
#pragma unroll
                for (int m = 0; m < 4; ++m)
#pragma unroll
                    for (int n = 0; n < 2; ++n) acc[a][b][m][n] = (f32x4){0.f, 0.f, 0.f, 0.f};
        cur = nxt; cA = nA; cB = nB; ++ui;
        if (wr == 1) PG8_BAR;
    }
    PG8_WAIT_V(0);
    PG8_BAR;
#undef PG8_SA
#undef PG8_SB
#undef PG8_STAGE
#undef PG8_LDA
#undef PG8_LDB
#undef PG8_MMA
#undef PG8_WAIT_V
#undef PG8_WAIT_L
#undef PG8_BAR
#undef PG8_SCHED
}
}

constexpr int NWAVES = 8;
constexpr int D = 1024, SEQ = 2048, NB = 8, M = NB * SEQ;
constexpr int INW = 2824, INW_G = 2816;
constexpr int C_Q = 0, C_K = 512, C_V = 640, C_DQKV = 768, C_DZ = 2304;
constexpr int NE = 32, TOPK = 4, DE2 = 2048;
constexpr float ALPHA = 1.41421356237309515f;
constexpr float LN_EPS = 1e-5f, RMS_EPS = 1e-6f;
constexpr int MPAD_MAX = M * TOPK + NE * 256;

constexpr size_t MiB = 1u << 20;
constexpr size_t WS_CTL = 0, CTL_ZERO_BYTES = 1 * MiB;
constexpr size_t WS_META = 1 * MiB;
constexpr size_t WS_WIN = 2 * MiB, WS_WOUT = 8 * MiB, WS_PW = 10 * MiB;
constexpr size_t WS_W1 = 16 * MiB, WS_W2 = 272 * MiB;
constexpr size_t WS_XB = 400 * MiB;
constexpr size_t WS_DAB = 432 * MiB;
constexpr size_t WS_G = 433 * MiB, WS_BETA = 434 * MiB;
constexpr size_t WS_TOPI = 435 * MiB, WS_TOPW = 436 * MiB, WS_TOKPOS = 437 * MiB, WS_SORTED = 438 * MiB;
constexpr size_t WS_MIX = 440 * MiB;
constexpr size_t WS_H = 472 * MiB;
constexpr size_t WS_X1 = 536 * MiB, WS_X2 = 600 * MiB;
constexpr size_t WS_POOLED = 664 * MiB;
constexpr size_t WS_SCR = 696 * MiB;
constexpr size_t WS_PROJ = WS_SCR;
constexpr size_t WS_QB = WS_SCR + 176 * MiB, WS_KB = WS_QB + 16 * MiB, WS_VB = WS_KB + 16 * MiB;
constexpr size_t WS_OO = WS_VB + 16 * MiB;
constexpr size_t WS_DNC = WS_OO + 32 * MiB;
constexpr size_t WS_GL = WS_DNC + 72 * MiB;
constexpr size_t WS_QA = WS_GL + 1 * MiB, WS_KA = WS_QA + 16 * MiB, WS_VA = WS_KA + 4 * MiB;
constexpr int DNC_BYTES = 73728, DNC_WF = 0, DNC_QF = 16384, DNC_QKF = 32768, DNC_KDF = 40960, DNC_UF = 57344;
constexpr size_t WS_XPERM = WS_SCR;
constexpr size_t WS_ACT = WS_SCR + 144 * MiB;
constexpr size_t WS_YS = WS_SCR + 288 * MiB;
constexpr size_t WS_END = WS_SCR + 576 * MiB;
constexpr int META_BHIST = 0, META_TILE_E = 8192, META_NTILES = 8192 + 512;

constexpr int CW_BAR = 4096;
constexpr int RING_OFF = 0, RING_BYTES = 131072;
constexpr int LDSCTL_OFF = 147456, MISC_OFF = LDSCTL_OFF + 320;
constexpr int LDS_BYTES = 151552;

#define GAS __attribute__((address_space(1)))
#define LAS __attribute__((address_space(3)))
typedef unsigned short bf16;
typedef unsigned v4u __attribute__((ext_vector_type(4)));
typedef unsigned v2u __attribute__((ext_vector_type(2)));
typedef float f32x4 __attribute__((ext_vector_type(4)));
#define LDS_WAIT() asm volatile("s_waitcnt lgkmcnt(0)" ::: "memory")
__device__ __forceinline__ unsigned f2bf(float f) { unsigned u = __builtin_bit_cast(unsigned, f); return (u + 0x7fffu + ((u >> 16) & 1u)) >> 16; }
__device__ __forceinline__ unsigned pk2(float lo, float hi) { return f2bf(lo) | (f2bf(hi) << 16); }

#define XB_TMO      128
#define XB_XCNT(j)  (256  + 64 * (j))
#define XB_XSUB(j)  (1280 + 64 * (j))
#define XB_XGEN(j)  (2304 + 64 * (j))
#define XB_TOP      3328
#define XB_TOPGEN   3392
#define XCD_BAR_WORDS 3456
#define XB_SPIN_CAP (1u << 18)
__device__ __forceinline__ unsigned xb_ld(unsigned* p)              { return __hip_atomic_load(p, __ATOMIC_RELAXED, __HIP_MEMORY_SCOPE_AGENT); }
__device__ __forceinline__ unsigned xb_add(unsigned* p, unsigned v) { return __hip_atomic_fetch_add(p, v, __ATOMIC_RELAXED, __HIP_MEMORY_SCOPE_AGENT); }
__device__ __forceinline__ unsigned xb_xcc_id() { return (unsigned)__builtin_amdgcn_s_getreg((3 << 11) | 20) & 0xFu; }
#define XB_SPIN(cond, bar) do { unsigned _sp = 0; while (cond) { __builtin_amdgcn_s_sleep(1); \
    if ((++_sp & 255u) == 0u) { if (xb_ld(&(bar)[XB_TMO])) break; if (_sp > XB_SPIN_CAP) { atomicAdd(&(bar)[XB_TMO], 1u); break; } } } } while (0)
struct XcdBarrier { unsigned* bar; unsigned x; volatile LAS unsigned* st; };
__device__ __forceinline__ XcdBarrier xcd_barrier_post(unsigned* bar, volatile LAS unsigned* st) {
    XcdBarrier b; b.bar = bar; b.x = xb_xcc_id(); b.st = st;
    if (threadIdx.x == 0) (void)xb_add(&bar[XB_XCNT(b.x)], 1u);
    return b;
}
__device__ __forceinline__ void xcd_barrier_complete(unsigned* bar, unsigned x, unsigned& nloc, unsigned& nx) {
    const unsigned G = gridDim.x * gridDim.y * gridDim.z;
    unsigned sum, cnt, mine, sp = 0u;
    for (;;) {
        sum = 0u; cnt = 0u; mine = 0u;
#pragma unroll
        for (unsigned j = 0; j < 16; ++j) { const unsigned c = xb_ld(&bar[XB_XCNT(j)]); sum += c; cnt += (c > 0u) ? 1u : 0u; mine = (j == x) ? c : mine; }
        if (sum == G) break;
        __builtin_amdgcn_s_sleep(1);
        if ((++sp & 255u) == 0u) { if (xb_ld(&bar[XB_TMO])) break; if (sp > XB_SPIN_CAP) { atomicAdd(&bar[XB_TMO], 1u); break; } }
    }
    nloc = mine > 0u ? mine : 1u; nx = cnt > 0u ? cnt : 1u;
}
__device__ __forceinline__ void xcd_barrier(const XcdBarrier& b) {
    asm volatile("s_waitcnt vmcnt(0)" ::: "memory");
    __syncthreads();
    if (threadIdx.x == 0) {
        unsigned* bar = b.bar;
        __builtin_amdgcn_s_waitcnt(0);
        unsigned nloc = b.st[0], nx = b.st[1];
        if (nloc == 0u) { xcd_barrier_complete(bar, b.x, nloc, nx); b.st[0] = nloc; b.st[1] = nx; }
        const unsigned old = xb_add(&bar[XB_XSUB(b.x)], 1u);
        const unsigned gen = old / nloc;
        if (old + 1u == (gen + 1u) * nloc) {
            __builtin_amdgcn_fence(__ATOMIC_RELEASE, "agent");
            asm volatile("s_waitcnt vmcnt(0)" ::: "memory");
            const unsigned og = xb_add(&bar[XB_TOP], 1u);
            const unsigned tg = og / nx;
            if (og + 1u == (tg + 1u) * nx) xb_add(&bar[XB_TOPGEN], 1u);
            else XB_SPIN(xb_ld(&bar[XB_TOPGEN]) == tg, bar);
            __builtin_amdgcn_fence(__ATOMIC_ACQUIRE, "agent");
            xb_add(&bar[XB_XGEN(b.x)], 1u);
            asm volatile("s_waitcnt vmcnt(0)" ::: "memory");
        } else {
            XB_SPIN(xb_ld(&bar[XB_XGEN(b.x)]) == gen, bar);
            __builtin_amdgcn_fence(__ATOMIC_ACQUIRE, "agent");
            asm volatile("s_waitcnt vmcnt(0)" ::: "memory");
        }
    }
    __syncthreads();
}

__device__ __forceinline__ float wave_sum(float v) {
#pragma unroll
    for (int o = 1; o < 64; o <<= 1) v += __shfl_xor(v, o);
    return v;
}
__device__ __forceinline__ float wave_max(float v) {
#pragma unroll
    for (int o = 1; o < 64; o <<= 1) v = fmaxf(v, __shfl_xor(v, o));
    return v;
}
__device__ __forceinline__ float sigmoidf_(float x) { return 1.0f / (1.0f + expf(-x)); }
__device__ __forceinline__ float siluf_(float x) { return x * sigmoidf_(x); }

__device__ __forceinline__ void p0_transpose_item(const float* W, int K, int ldw, int nblk, bf16* WT, LAS float* scr, int item, int lane) {
    const int kb = item / nblk, nb = item % nblk, k0 = 64 * kb, n0 = 32 * nb;
#pragma unroll 8
    for (int i = 0; i < 32; ++i) { const int kk = 2 * i + (lane >> 5); scr[kk * 33 + (lane & 31)] = W[(size_t)(k0 + kk) * ldw + n0 + (lane & 31)]; }
    LDS_WAIT(); asm volatile("" ::: "memory");
    const int c = lane & 7;
#pragma unroll
    for (int j = 0; j < 4; ++j) { const int n = (lane >> 3) + 8 * j; const LAS float* s = scr + (8 * c) * 33 + n;
        v4u o; o.x = pk2(s[0 * 33], s[1 * 33]); o.y = pk2(s[2 * 33], s[3 * 33]); o.z = pk2(s[4 * 33], s[5 * 33]); o.w = pk2(s[6 * 33], s[7 * 33]);
        *(GAS v4u*)(WT + (size_t)(n0 + n) * K + k0 + 8 * c) = o; }
    LDS_WAIT(); asm volatile("" ::: "memory");
}


typedef short bf16x8v __attribute__((ext_vector_type(8)));
__device__ __forceinline__ unsigned pkbf(float a, float b) {
    typedef float f2_ __attribute__((ext_vector_type(2))); typedef __bf16 b2_ __attribute__((ext_vector_type(2)));
    f2_ v = {a, b}; b2_ r = __builtin_convertvector(v, b2_); return __builtin_bit_cast(unsigned, r);
}
__device__ __forceinline__ bf16x8v pack8(const f32x4& a, const f32x4& b) { v4u w; w.x = pkbf(a.x, a.y); w.y = pkbf(a.z, a.w); w.z = pkbf(b.x, b.y); w.w = pkbf(b.z, b.w); return __builtin_bit_cast(bf16x8v, w); }
__device__ __forceinline__ float bflo(unsigned w) { return __builtin_bit_cast(float, w << 16); }
__device__ __forceinline__ float bfhi(unsigned w) { return __builtin_bit_cast(float, w & 0xffff0000u); }
__device__ __forceinline__ void tr_read2(unsigned a0, unsigned a1, v2u& r0, v2u& r1) {
    asm volatile("ds_read_b64_tr_b16 %0, %2\n\tds_read_b64_tr_b16 %1, %3\n\ts_waitcnt lgkmcnt(0)" : "=&v"(r0), "=&v"(r1) : "v"(a0), "v"(a1) : "memory");
}
template <int OFF> __device__ __forceinline__ void tr_read10(unsigned base, v2u (&r)[10]) {
    asm volatile("ds_read_b64_tr_b16 %0, %10 offset:%11\n\tds_read_b64_tr_b16 %1, %10 offset:%12\n\tds_read_b64_tr_b16 %2, %10 offset:%13\n\tds_read_b64_tr_b16 %3, %10 offset:%14\n\t"
                 "ds_read_b64_tr_b16 %4, %10 offset:%15\n\tds_read_b64_tr_b16 %5, %10 offset:%16\n\tds_read_b64_tr_b16 %6, %10 offset:%17\n\tds_read_b64_tr_b16 %7, %10 offset:%18\n\t"
                 "ds_read_b64_tr_b16 %8, %10 offset:%19\n\tds_read_b64_tr_b16 %9, %10 offset:%20\n\ts_waitcnt lgkmcnt(0)"
                 : "=&v"(r[0]), "=&v"(r[1]), "=&v"(r[2]), "=&v"(r[3]), "=&v"(r[4]), "=&v"(r[5]), "=&v"(r[6]), "=&v"(r[7]), "=&v"(r[8]), "=&v"(r[9])
                 : "v"(base), "i"(OFF), "i"(OFF + 2304), "i"(OFF + 4608), "i"(OFF + 4608 + 2304), "i"(OFF + 9216), "i"(OFF + 9216 + 2304), "i"(OFF + 13824), "i"(OFF + 13824 + 2304), "i"(OFF + 18432), "i"(OFF + 18432 + 2304)
                 : "memory");
}
#define MFMA16(a, b, c) __builtin_amdgcn_mfma_f32_16x16x32_bf16((a), (b), (c), 0, 0, 0)

struct Args { const float* in[24]; float* out; unsigned char* ws; int ph_lo, ph_hi; };

typedef const __attribute__((address_space(4))) Args CArgs;
__device__ __forceinline__ CArgs* kargs() { CArgs* p = (CArgs*)__builtin_amdgcn_kernarg_segment_ptr(); asm volatile("" : "+s"(p)); return p; }
#define PH_BEGIN CArgs* A_ = kargs(); unsigned char* ws = A_->ws; (void)ws; int tid_l_ = threadIdx.x; asm volatile("" : "+v"(tid_l_)); const int tid = tid_l_, lane = tid_l_ & 63; (void)tid; (void)lane;
#define INP(i) (A_->in[i])
#define WSP(T, off) ((T*)(ws + (off)))
__global__ void __launch_bounds__(NWAVES * 64, 2) hybrid_fwd(Args args) {
    extern __shared__ __attribute__((aligned(16))) unsigned char lds[];
    LAS unsigned char* L = (LAS unsigned char*)lds;
    volatile LAS unsigned* MISC = (volatile LAS unsigned*)(L + MISC_OFF);
    const int tid = threadIdx.x, lane = tid & 63, wave = __builtin_amdgcn_readfirstlane(tid >> 6);
    const int G = gridDim.x, blk = blockIdx.x;
    const int gw = blk * NWAVES + wave, NGW = G * NWAVES;
    unsigned* ctl = (unsigned*)(args.ws + WS_CTL);
    for (int u = tid; u < (LDS_BYTES - LDSCTL_OFF) / 4; u += NWAVES * 64) ((LAS unsigned*)(L + LDSCTL_OFF))[u] = 0u;
    __syncthreads();
    XcdBarrier bar; bar.bar = ctl + CW_BAR; bar.x = 0; bar.st = nullptr;
    if (MK_N_LAUNCHES == 1) bar = xcd_barrier_post(ctl + CW_BAR, MISC + 8);
    const int lo = args.ph_lo, hi = args.ph_hi;
#ifndef PH_MASK
#define PH_MASK 0xFFFFFFFFu
#endif
#define IN(k) (lo <= (k) && (k) < hi && ((PH_MASK >> ((k) > 13 ? (k) - 7 : (k))) & 1u))
#define SEAM(k) do { if (IN(k) && IN((k) + 1)) xcd_barrier(bar); } while (0)

    if (IN(0)) {
        PH_BEGIN const float* x_in = INP(0); const float* w_in = INP(2); const float* b_in = INP(3); const float* w_out = INP(9); const float* pool_w = INP(11); const float* moe_w1 = INP(18); const float* moe_w2 = INP(20); bf16* WIN_T = WSP(bf16, WS_WIN); bf16* WOUT_T = WSP(bf16, WS_WOUT); bf16* PW_T = WSP(bf16, WS_PW); bf16* W1T = WSP(bf16, WS_W1); bf16* W2T = WSP(bf16, WS_W2); bf16* XB = WSP(bf16, WS_XB); float* DAB = WSP(float, WS_DAB);
        LAS float* scr = (LAS float*)(L + RING_OFF + wave * 16384);
        constexpr int I_IN = 16 * 88, I_OUT = 16 * 32, I_PW = 4 * 8, I_W1 = 16 * 64, I_W2 = 16 * 32;
        constexpr int S1 = I_IN, S2 = S1 + I_OUT, S3 = S2 + 4 * I_PW, S4 = S3 + 64 * I_W1, S5 = S4 + 64 * I_W2;
        for (int it = gw; it < S5; it += NGW) {
            if (it < S1) p0_transpose_item(w_in, 1024, INW, 88, WIN_T, scr, it, lane);
            else if (it < S2) p0_transpose_item(w_out, 1024, 1024, 32, WOUT_T, scr, it - S1, lane);
            else if (it < S3) { const int r = it - S2, g = r / I_PW; p0_transpose_item(pool_w + (size_t)g * 65536, 256, 256, 8, PW_T + (size_t)g * 65536, scr, r % I_PW, lane); }
            else if (it < S4) { const int r = it - S3, mt = r / I_W1; p0_transpose_item(moe_w1 + (size_t)mt * 2097152, 1024, 2048, 64, W1T + (size_t)mt * 2097152, scr, r % I_W1, lane); }
            else { const int r = it - S4, mt = r / I_W2; p0_transpose_item(moe_w2 + (size_t)mt * 1048576, 1024, 1024, 32, W2T + (size_t)mt * 1048576, scr, r % I_W2, lane); }
        }
        for (int m = gw; m < M; m += NGW) {
            const GAS f32x4* xr = (const GAS f32x4*)(x_in + (size_t)m * D) + lane;
            GAS v2u* o8 = (GAS v2u*)(XB + (size_t)m * D) + lane;
            float acc8[8];
#pragma unroll
            for (int q = 0; q < 8; ++q) acc8[q] = 0.f;
#pragma unroll
            for (int j = 0; j < 4; ++j) { const f32x4 v = xr[64 * j]; v2u w; w.x = pk2(v.x, v.y); w.y = pk2(v.z, v.w); o8[64 * j] = w;
#pragma unroll
                for (int c = 0; c < 4; ++c) { const int col = 256 * j + 4 * lane + c; const float xv = v[c];
                    const f32x4 wa = *(const GAS f32x4*)(w_in + (size_t)col * INW + INW_G), wb = *(const GAS f32x4*)(w_in + (size_t)col * INW + INW_G + 4);
                    acc8[0] += xv * wa.x; acc8[1] += xv * wa.y; acc8[2] += xv * wa.z; acc8[3] += xv * wa.w;
                    acc8[4] += xv * wb.x; acc8[5] += xv * wb.y; acc8[6] += xv * wb.z; acc8[7] += xv * wb.w; } }
#pragma unroll
            for (int q = 0; q < 8; ++q) acc8[q] = wave_sum(acc8[q]);
            if (lane < 8) { float r = 0.f;
#pragma unroll
                for (int q = 0; q < 8; ++q) r = (lane == q) ? acc8[q] : r;
                DAB[(size_t)m * 8 + lane] = r + b_in[INW_G + lane]; }
        }
    }
    SEAM(0);
    if (IN(1)) {
        PH_BEGIN const float* b_in = INP(3); bf16* WIN_T = WSP(bf16, WS_WIN); bf16* XB = WSP(bf16, WS_XB); float* PROJ = WSP(float, WS_PROJ);
        pg8::Gemm g{XB, WIN_T, 1024, 1024, 1024}; pg8::StaticOrder S; S.init(M, INW_G, G, blk);
        pg8::EpiF32 E{PROJ, INW_G, b_in, nullptr};
        pg8::gemm_phase<pg8::EpiF32, pg8::StaticOrder>(L + RING_OFF, g, S, E);
    }
    SEAM(1);
    if (IN(2)) {
        PH_BEGIN const int* positions = (const int*)INP(1); const float* conv_w = INP(4); const float* a_log = INP(5); const float* dt_bias = INP(6); float* PROJ = WSP(float, WS_PROJ); bf16* QB = WSP(bf16, WS_QB); bf16* KB = WSP(bf16, WS_KB); bf16* VB = WSP(bf16, WS_VB); float* DAB = WSP(float, WS_DAB); float* GG = WSP(float, WS_G); float* BETA = WSP(float, WS_BETA); bf16* QA = WSP(bf16, WS_QA); bf16* KA = WSP(bf16, WS_KA); bf16* VA = WSP(bf16, WS_VA);
        for (int m = gw; m < M; m += NGW) {
            const float pos = (float)positions[m];
            const float invf[8] = {1.0f, 0.19392274f, 0.03760603f, 0.0072926646f, 0.0014142136f, 0.0002742482f, 5.3182957e-05f, 1.0313385e-05f};
            float cs[8], sn[8];
#pragma unroll
            for (int i = 0; i < 8; ++i) { const float ang = pos * invf[i]; cs[i] = cosf(ang); sn[i] = sinf(ang); }
            const float* row = PROJ + (size_t)m * INW_G;
            const int sub = lane & 7;
#pragma unroll
            for (int part = 0; part < 3; ++part) {
                const int cbase = part == 0 ? C_Q : part == 1 ? C_K : C_V;
                float v[8];
                if (part == 0 || lane < 16) { const f32x4 a = *(const GAS f32x4*)(row + cbase + lane * 8), c = *(const GAS f32x4*)(row + cbase + lane * 8 + 4);
                    v[0] = a.x; v[1] = a.y; v[2] = a.z; v[3] = a.w; v[4] = c.x; v[5] = c.y; v[6] = c.z; v[7] = c.w; }
                else {
#pragma unroll
                    for (int i = 0; i < 8; ++i) v[i] = 0.f; }
                if (part < 2) {
#pragma unroll
                    for (int i = 0; i < 8; ++i) { const float o = __shfl_xor(v[i], 1);
                        if (sub == 0) v[i] = v[i] * cs[i] - o * sn[i]; else if (sub == 1) v[i] = v[i] * cs[i] + o * sn[i]; }
                }
                const float sc = part == 0 ? 0.125f : 1.0f;
                v4u w; w.x = pk2(v[0] * sc, v[1] * sc); w.y = pk2(v[2] * sc, v[3] * sc); w.z = pk2(v[4] * sc, v[5] * sc); w.w = pk2(v[6] * sc, v[7] * sc);
                if (part == 0) *(GAS v4u*)(QA + (size_t)m * 512 + lane * 8) = w;
                else if (lane < 16) *(GAS v4u*)((part == 1 ? KA : VA) + (size_t)m * 128 + lane * 8) = w;
            }
        }
        for (int it = gw; it < M * 4; it += NGW) {
            const int m = it >> 2, h = it & 3, tt = m & (SEQ - 1);
            float ss[3];
            float vals[3][2];
#pragma unroll
            for (int c = 0; c < 3; ++c) {
                const int ch = c * 512 + h * 128 + lane * 2;
                float a0 = 0.f, a1 = 0.f;
#pragma unroll
                for (int j = 0; j < 4; ++j) { const int dt = 3 - j; if (tt - dt >= 0) { const float* pr = PROJ + (size_t)(m - dt) * INW_G + C_DQKV + ch;
                        a0 += conv_w[j * 1536 + ch] * pr[0]; a1 += conv_w[j * 1536 + ch + 1] * pr[1]; } }
                a0 = siluf_(a0); a1 = siluf_(a1);
                vals[c][0] = a0; vals[c][1] = a1; ss[c] = wave_sum(a0 * a0 + a1 * a1);
            }
            const float rq = rsqrtf(ss[0] + RMS_EPS) * 0.08838834764831845f, rk = rsqrtf(ss[1] + RMS_EPS);
            const size_t o = ((size_t)m * 4 + h) * 128 + lane * 2;
            *(unsigned*)(QB + o) = pk2(vals[0][0] * rq, vals[0][1] * rq); *(unsigned*)(KB + o) = pk2(vals[1][0] * rk, vals[1][1] * rk); *(unsigned*)(VB + o) = pk2(vals[2][0], vals[2][1]);
            if (lane == 0) { const float da = DAB[(size_t)m * 8 + h], db = DAB[(size_t)m * 8 + 4 + h];
                const float xx = da + dt_bias[h]; const float sp = xx > 20.f ? xx : log1pf(expf(xx));
                GG[(size_t)m * 4 + h] = -expf(a_log[h]) * sp; BETA[(size_t)m * 4 + h] = sigmoidf_(db); }
        }
    }
    SEAM(2);
    if (IN(3)) {
        PH_BEGIN const float* sinks = INP(8); float* PROJ = WSP(float, WS_PROJ); bf16* QB = WSP(bf16, WS_QB); bf16* KB = WSP(bf16, WS_KB); bf16* VB = WSP(bf16, WS_VB); float* GG = WSP(float, WS_G); float* BETA = WSP(float, WS_BETA); bf16* MIX = WSP(bf16, WS_MIX); unsigned char* DNC = WSP(unsigned char, WS_DNC); float* GLB = WSP(float, WS_GL);
        {
            constexpr int KP = 272, TP = 144, AP = 68;
            constexpr int O_K = 0, O_V = 17408, O_A = 34816, O_TU = 52224, O_TW = 61440, O_GC = 70656, O_BT = 70912;
            LAS unsigned char* Kimg = L + O_K; LAS unsigned char* Vimg = L + O_V; LAS float* Amat = (LAS float*)(L + O_A);
            LAS unsigned char* Tuimg = L + O_TU; LAS unsigned char* Twimg = L + O_TW; LAS float* gcL = (LAS float*)(L + O_GC); LAS float* btL = (LAS float*)(L + O_BT);
            const unsigned lbase = (unsigned)(size_t)L;
            const int x = lane & 15, g = lane >> 4;
            for (int u = blk; u < 1024; u += G) {
                const int bh = u >> 5, c = u & 31, h = bh & 3; const size_t row0 = (size_t)(bh >> 2) * SEQ + c * 64;
                unsigned char* dn = DNC + (size_t)u * DNC_BYTES;
#pragma unroll
                for (int i = 0; i < 2; ++i) { const int piece = tid + 512 * i, row = piece >> 4, sg = piece & 15;
                    const size_t so = ((row0 + row) * 4 + h) * 128 + sg * 8;
                    *(LAS v4u*)(Kimg + row * KP + sg * 16) = *(const GAS v4u*)(KB + so); *(LAS v4u*)(Vimg + row * KP + sg * 16) = *(const GAS v4u*)(VB + so); }
                if (wave == 0) { float v = GG[(row0 + lane) * 4 + h];
#pragma unroll
                    for (int o = 1; o < 64; o <<= 1) { const float t = __shfl_up(v, o); if (lane >= o) v += t; }
                    gcL[lane] = v; btL[lane] = BETA[(row0 + lane) * 4 + h]; }
                __syncthreads();
                {
                    const int it = wave >> 1, ks2 = wave & 1;
                    f32x4 akk[2], aqk[2];
#pragma unroll
                    for (int t2 = 0; t2 < 2; ++t2) { akk[t2] = (f32x4){0.f, 0.f, 0.f, 0.f}; aqk[t2] = (f32x4){0.f, 0.f, 0.f, 0.f}; }
#pragma unroll
                    for (int ks = 0; ks < 4; ++ks) {
                        const bf16x8v ki = *(const LAS bf16x8v*)(Kimg + (16 * it + x) * KP + (32 * ks + 8 * g) * 2);
                        const bf16x8v qi = *(const GAS bf16x8v*)(QB + ((row0 + 16 * it + x) * 4 + h) * 128 + 32 * ks + 8 * g);
#pragma unroll
                        for (int t2 = 0; t2 < 2; ++t2) { const bf16x8v kj = *(const LAS bf16x8v*)(Kimg + (16 * (2 * ks2 + t2) + x) * KP + (32 * ks + 8 * g) * 2);
                            akk[t2] = MFMA16(kj, ki, akk[t2]); aqk[t2] = MFMA16(kj, qi, aqk[t2]); }
                    }
                    const int i = 16 * it + x; const float gci = gcL[i], bi = btL[i];
                    f32x4 e[2];
#pragma unroll
                    for (int t2 = 0; t2 < 2; ++t2) { const int j0 = 16 * (2 * ks2 + t2) + 4 * g; const f32x4 gcj = *(const LAS f32x4*)(gcL + j0); f32x4 av;
#pragma unroll
                        for (int r = 0; r < 4; ++r) { const int j = j0 + r; const float dec = (j <= i) ? __expf(gci - gcj[r]) : 0.f;
                            av[r] = (j < i) ? bi * akk[t2][r] * dec : 0.f; e[t2][r] = aqk[t2][r] * dec; }
                        *(LAS f32x4*)(Amat + i * AP + j0) = av; }
                    *(GAS bf16x8v*)(dn + DNC_QKF + ((it * 2 + ks2) * 64 + lane) * 16) = pack8(e[0], e[1]);
                }
                __syncthreads();
                if (wave == 0) {
                    float Tc[64];
#pragma unroll
                    for (int i = 0; i < 64; ++i) Tc[i] = 0.f;
#pragma unroll
                    for (int i = 0; i < 64; ++i) { float sacc = 0.f;
#pragma unroll
                        for (int j4 = 0; j4 < (i + 3) / 4; ++j4) { const f32x4 av = *(const LAS f32x4*)(Amat + i * AP + 4 * j4);
                            sacc += av.x * Tc[4 * j4] + av.y * Tc[4 * j4 + 1] + av.z * Tc[4 * j4 + 2] + av.w * Tc[4 * j4 + 3]; }
                        Tc[i] = (lane == i ? 1.f : 0.f) - sacc; }
                    const float bc = btL[lane], ec = bc * __expf(gcL[lane]);
#pragma unroll
                    for (int i = 0; i < 64; ++i) { *(LAS unsigned short*)(Tuimg + i * TP + lane * 2) = (unsigned short)f2bf(Tc[i] * bc); *(LAS unsigned short*)(Twimg + i * TP + lane * 2) = (unsigned short)f2bf(Tc[i] * ec); }
                } else {
                    const float gclast = gcL[63];
                    for (int jb = wave - 1; jb < 32; jb += 7) {
                        if (jb < 16) { const int mt = jb >> 2, ks = jb & 3; const int i = 16 * mt + x; const float sc = __expf(gcL[i]);
                            const bf16* qp = QB + ((row0 + i) * 4 + h) * 128 + 32 * ks + 4 * g;
                            const v2u p0 = *(const GAS v2u*)qp, p1 = *(const GAS v2u*)(qp + 16);
                            v4u w; w.x = pkbf(bflo(p0.x) * sc, bfhi(p0.x) * sc); w.y = pkbf(bflo(p0.y) * sc, bfhi(p0.y) * sc); w.z = pkbf(bflo(p1.x) * sc, bfhi(p1.x) * sc); w.w = pkbf(bflo(p1.y) * sc, bfhi(p1.y) * sc);
                            *(GAS v4u*)(dn + DNC_QF + ((mt * 4 + ks) * 64 + lane) * 16) = w;
                        } else { const int dt = (jb - 16) >> 1, ks2 = (jb - 16) & 1; const int q = x >> 2, p = x & 3;
                            const int j0 = 32 * ks2 + 4 * g;
                            v2u r0, r1; tr_read2(lbase + O_K + (j0 + q) * KP + (16 * dt + 4 * p) * 2, lbase + O_K + (j0 + 16 + q) * KP + (16 * dt + 4 * p) * 2, r0, r1);
                            const f32x4 g0 = *(const LAS f32x4*)(gcL + j0), g1 = *(const LAS f32x4*)(gcL + j0 + 16);
                            v4u w; w.x = pkbf(bflo(r0.x) * __expf(gclast - g0.x), bfhi(r0.x) * __expf(gclast - g0.y)); w.y = pkbf(bflo(r0.y) * __expf(gclast - g0.z), bfhi(r0.y) * __expf(gclast - g0.w));
                            w.z = pkbf(bflo(r1.x) * __expf(gclast - g1.x), bfhi(r1.x) * __expf(gclast - g1.y)); w.w = pkbf(bflo(r1.y) * __expf(gclast - g1.z), bfhi(r1.y) * __expf(gclast - g1.w));
                            *(GAS v4u*)(dn + DNC_KDF + ((dt * 2 + ks2) * 64 + lane) * 16) = w; }
                    }
                }
                __syncthreads();
                {
                    const int q = x >> 2, p = x & 3;
                    bf16x8v vf[2];
#pragma unroll
                    for (int ks2 = 0; ks2 < 2; ++ks2) { v2u r0, r1; const int j0 = 32 * ks2 + 8 * g;
                        tr_read2(lbase + O_V + (j0 + q) * KP + (16 * wave + 4 * p) * 2, lbase + O_V + (j0 + 4 + q) * KP + (16 * wave + 4 * p) * 2, r0, r1);
                        v4u w; w.x = r0.x; w.y = r0.y; w.z = r1.x; w.w = r1.y; vf[ks2] = __builtin_bit_cast(bf16x8v, w); }
#pragma unroll
                    for (int mt = 0; mt < 4; ++mt) { f32x4 acc = (f32x4){0.f, 0.f, 0.f, 0.f};
#pragma unroll
                        for (int ks2 = 0; ks2 < 2; ++ks2) { const bf16x8v tf = *(const LAS bf16x8v*)(Tuimg + (16 * mt + x) * TP + (32 * ks2 + 8 * g) * 2); acc = MFMA16(tf, vf[ks2], acc); }
                        v2u w; w.x = pkbf(acc.x, acc.y); w.y = pkbf(acc.z, acc.w);
                        *(GAS v2u*)(dn + DNC_UF + ((wave * 4 + mt) * 64 + lane) * 8) = w; }
                    const int it = wave >> 1;
                    bf16x8v twf[2];
#pragma unroll
                    for (int ks2 = 0; ks2 < 2; ++ks2) twf[ks2] = *(const LAS bf16x8v*)(Twimg + (16 * it + x) * TP + (32 * ks2 + 8 * g) * 2);
#pragma unroll
                    for (int kk2 = 0; kk2 < 2; ++kk2) { const int ks = 2 * (wave & 1) + kk2; f32x4 acc[2];
#pragma unroll
                        for (int t2 = 0; t2 < 2; ++t2) { const int dt = 2 * ks + t2; acc[t2] = (f32x4){0.f, 0.f, 0.f, 0.f};
#pragma unroll
                            for (int ks2 = 0; ks2 < 2; ++ks2) { v2u r0, r1; const int j0 = 32 * ks2 + 8 * g;
                                tr_read2(lbase + O_K + (j0 + q) * KP + (16 * dt + 4 * p) * 2, lbase + O_K + (j0 + 4 + q) * KP + (16 * dt + 4 * p) * 2, r0, r1);
                                v4u w; w.x = r0.x; w.y = r0.y; w.z = r1.x; w.w = r1.y; acc[t2] = MFMA16(__builtin_bit_cast(bf16x8v, w), twf[ks2], acc[t2]); } }
                        *(GAS bf16x8v*)(dn + DNC_WF + ((it * 4 + ks) * 64 + lane) * 16) = pack8(-acc[0], -acc[1]); }
                    if (tid == 0) GLB[u] = __expf(gcL[63]);
                }
                __syncthreads();
            }
        }
        {
            constexpr int VP = 144, O_KI = 0, O_VI = 272 * VP;
            const bf16* QA = WSP(bf16, WS_QA); const bf16* KA = WSP(bf16, WS_KA); const bf16* VA = WSP(bf16, WS_VA);
            const unsigned lbase = (unsigned)(size_t)L; const int x = lane & 15, g = lane >> 4;
            for (int u = blk; u < 256; u += G) {
                const int b = u >> 5, n = (u >> 1) & 15, kvh = u & 1;
                const long rowb = (long)b * SEQ + (long)(n - 1) * 128;
                for (int pc = tid; pc < 272 * 8; pc += 512) { const int row = pc >> 3, sg = pc & 7; v4u kv = {0u, 0u, 0u, 0u}, vv = {0u, 0u, 0u, 0u};
                    if (row < 256 && (n > 0 || row >= 128)) { const size_t so = (size_t)(rowb + row) * 128 + kvh * 64 + sg * 8; kv = *(const GAS v4u*)(KA + so); vv = *(const GAS v4u*)(VA + so); }
                    *(LAS v4u*)(L + O_KI + row * VP + sg * 16) = kv; *(LAS v4u*)(L + O_VI + row * VP + sg * 16) = vv; }
                __syncthreads();
                const int hq = kvh * 4 + (wave >> 1); const float sink = sinks[hq];
                for (int t = 0; t < 4; ++t) {
                    const int qi0 = 64 * (wave & 1) + 16 * t, ktb = qi0 >> 4, qi = qi0 + x;
                    const size_t qrow = (size_t)b * SEQ + n * 128 + qi;
                    bf16x8v qf[2];
#pragma unroll
                    for (int ks = 0; ks < 2; ++ks) qf[ks] = *(const GAS bf16x8v*)(QA + qrow * 512 + hq * 64 + 32 * ks + 8 * g);
                    f32x4 sc[10];
                    float mx = sink;
#pragma unroll
                    for (int kk = 0; kk < 9; ++kk) { f32x4 acc = (f32x4){0.f, 0.f, 0.f, 0.f};
#pragma unroll
                        for (int ks = 0; ks < 2; ++ks) { const bf16x8v kf = *(const LAS bf16x8v*)(L + O_KI + (16 * (ktb + kk) + x) * VP + (32 * ks + 8 * g) * 2); acc = MFMA16(kf, qf[ks], acc); }
#pragma unroll
                        for (int r = 0; r < 4; ++r) { const int kj = 16 * (ktb + kk) + 4 * g + r; const bool ok = (kj >= qi + 1) && (kj <= qi + 128) && (n > 0 || kj >= 128);
                            acc[r] = ok ? acc[r] : -INFINITY; mx = fmaxf(mx, acc[r]); }
                        sc[kk] = acc; }
                    mx = fmaxf(mx, __shfl_xor(mx, 16)); mx = fmaxf(mx, __shfl_xor(mx, 32));
                    float sum = 0.f;
#pragma unroll
                    for (int kk = 0; kk < 9; ++kk)
#pragma unroll
                        for (int r = 0; r < 4; ++r) { const float p = __expf(sc[kk][r] - mx); sc[kk][r] = p; sum += p; }
                    sc[9] = (f32x4){0.f, 0.f, 0.f, 0.f};
                    sum += __shfl_xor(sum, 16); sum += __shfl_xor(sum, 32);
                    const float inv = 1.0f / (sum + __expf(sink - mx));
                    bf16x8v Pb[5];
#pragma unroll
                    for (int pp = 0; pp < 5; ++pp) Pb[pp] = pack8(sc[2 * pp], sc[2 * pp + 1]);
                    const unsigned vb = lbase + O_VI + (16 * ktb + 4 * g + (x >> 2)) * VP + (4 * (x & 3)) * 2;
                    f32x4 o[4];
                    { v2u r[10]; tr_read10<0>(vb, r); o[0] = (f32x4){0.f, 0.f, 0.f, 0.f};
#pragma unroll
                      for (int pp = 0; pp < 5; ++pp) { v4u w; w.x = r[2 * pp].x; w.y = r[2 * pp].y; w.z = r[2 * pp + 1].x; w.w = r[2 * pp + 1].y; o[0] = MFMA16(__builtin_bit_cast(bf16x8v, w), Pb[pp], o[0]); } }
                    { v2u r[10]; tr_read10<32>(vb, r); o[1] = (f32x4){0.f, 0.f, 0.f, 0.f};
#pragma unroll
                      for (int pp = 0; pp < 5; ++pp) { v4u w; w.x = r[2 * pp].x; w.y = r[2 * pp].y; w.z = r[2 * pp + 1].x; w.w = r[2 * pp + 1].y; o[1] = MFMA16(__builtin_bit_cast(bf16x8v, w), Pb[pp], o[1]); } }
                    { v2u r[10]; tr_read10<64>(vb, r); o[2] = (f32x4){0.f, 0.f, 0.f, 0.f};
#pragma unroll
                      for (int pp = 0; pp < 5; ++pp) { v4u w; w.x = r[2 * pp].x; w.y = r[2 * pp].y; w.z = r[2 * pp + 1].x; w.w = r[2 * pp + 1].y; o[2] = MFMA16(__builtin_bit_cast(bf16x8v, w), Pb[pp], o[2]); } }
                    { v2u r[10]; tr_read10<96>(vb, r); o[3] = (f32x4){0.f, 0.f, 0.f, 0.f};
#pragma unroll
                      for (int pp = 0; pp < 5; ++pp) { v4u w; w.x = r[2 * pp].x; w.y = r[2 * pp].y; w.z = r[2 * pp + 1].x; w.w = r[2 * pp + 1].y; o[3] = MFMA16(__builtin_bit_cast(bf16x8v, w), Pb[pp], o[3]); } }
#pragma unroll
                    for (int dt = 0; dt < 4; ++dt) { v2u w; w.x = pkbf(o[dt].x * inv, o[dt].y * inv); w.y = pkbf(o[dt].z * inv, o[dt].w * inv);
                        *(GAS v2u*)(MIX + qrow * 1024 + hq * 64 + 16 * dt + 4 * g) = w; }
                }
                __syncthreads();
            }
        }
    }
    SEAM(3);
    if (IN(4)) {
        PH_BEGIN float* OO = WSP(float, WS_OO); unsigned char* DNC = WSP(unsigned char, WS_DNC); float* GLB = WSP(float, WS_GL);
        if (blk < 32) {
            const int h = blk & 3; const size_t row0 = (size_t)(blk >> 2) * SEQ; const int x = lane & 15, g = lane >> 4;
            const unsigned char* dn0 = DNC + (size_t)blk * 32 * DNC_BYTES;
            f32x4 S[8];
#pragma unroll
            for (int d = 0; d < 8; ++d) S[d] = (f32x4){0.f, 0.f, 0.f, 0.f};
#pragma unroll
            for (int p = 0; p < 9; ++p) __builtin_amdgcn_global_load_lds((const unsigned*)(dn0 + p * 8192 + tid * 16), (LAS unsigned*)(L + p * 8192 + wave * 1024), 16, 0, 0);
            for (int n = 0; n < 32; ++n) {
                asm volatile("s_waitcnt vmcnt(0)" ::: "memory"); __builtin_amdgcn_s_barrier(); asm volatile("" ::: "memory");
                if (n + 1 < 32) { const unsigned char* src = dn0 + (size_t)(n + 1) * DNC_BYTES; LAS unsigned char* dst = L + ((n + 1) & 1) * DNC_BYTES;
#pragma unroll
                    for (int p = 0; p < 9; ++p) __builtin_amdgcn_global_load_lds((const unsigned*)(src + p * 8192 + tid * 16), (LAS unsigned*)(dst + p * 8192 + wave * 1024), 16, 0, 0); }
                const LAS unsigned char* buf = L + (n & 1) * DNC_BYTES;
                const float gl = GLB[blk * 32 + n];
                bf16x8v Sb[4];
#pragma unroll
                for (int ks = 0; ks < 4; ++ks) Sb[ks] = pack8(S[2 * ks], S[2 * ks + 1]);
                f32x4 av[4], ao[4];
#pragma unroll
                for (int mt = 0; mt < 4; ++mt) { const v2u uw = *(const LAS v2u*)(buf + DNC_UF + ((wave * 4 + mt) * 64 + lane) * 8);
                    av[mt] = (f32x4){bflo(uw.x), bfhi(uw.x), bflo(uw.y), bfhi(uw.y)}; ao[mt] = (f32x4){0.f, 0.f, 0.f, 0.f}; }
#pragma unroll
                for (int mt = 0; mt < 4; ++mt)
#pragma unroll
                    for (int ks = 0; ks < 4; ++ks) { const bf16x8v wf = *(const LAS bf16x8v*)(buf + DNC_WF + ((mt * 4 + ks) * 64 + lane) * 16), qf = *(const LAS bf16x8v*)(buf + DNC_QF + ((mt * 4 + ks) * 64 + lane) * 16);
                        av[mt] = MFMA16(wf, Sb[ks], av[mt]); ao[mt] = MFMA16(qf, Sb[ks], ao[mt]); }
                bf16x8v Vb[2];
#pragma unroll
                for (int ks2 = 0; ks2 < 2; ++ks2) Vb[ks2] = pack8(av[2 * ks2], av[2 * ks2 + 1]);
#pragma unroll
                for (int mt = 0; mt < 4; ++mt)
#pragma unroll
                    for (int ks2 = 0; ks2 < 2; ++ks2) { const bf16x8v qkf = *(const LAS bf16x8v*)(buf + DNC_QKF + ((mt * 2 + ks2) * 64 + lane) * 16); ao[mt] = MFMA16(qkf, Vb[ks2], ao[mt]); }
#pragma unroll
                for (int d = 0; d < 8; ++d) { S[d] = S[d] * gl;
#pragma unroll
                    for (int ks2 = 0; ks2 < 2; ++ks2) { const bf16x8v kf = *(const LAS bf16x8v*)(buf + DNC_KDF + ((d * 2 + ks2) * 64 + lane) * 16); S[d] = MFMA16(kf, Vb[ks2], S[d]); } }
#pragma unroll
                for (int mt = 0; mt < 4; ++mt)
#pragma unroll
                    for (int r = 0; r < 4; ++r) OO[((row0 + 64 * n + 16 * mt + 4 * g + r) * 4 + h) * 128 + 16 * wave + x] = ao[mt][r];
            }
        }
    }
    SEAM(4);
    if (IN(5)) {
        PH_BEGIN const float* norm_w = INP(7); float* PROJ = WSP(float, WS_PROJ); float* OO = WSP(float, WS_OO); bf16* MIX = WSP(bf16, WS_MIX);
        for (int it = gw; it < M * 4; it += NGW) {
            const int m = it >> 2, h = it & 3;
            const float* op = OO + ((size_t)m * 4 + h) * 128 + lane * 2;
            const float o0 = op[0], o1 = op[1];
            const float r = rsqrtf(wave_sum(o0 * o0 + o1 * o1) * (1.0f / 128.0f) + RMS_EPS);
            const float* zp = PROJ + (size_t)m * INW_G + C_DZ + h * 128 + lane * 2;
            const float y0 = o0 * r * norm_w[lane * 2] * siluf_(zp[0]), y1 = o1 * r * norm_w[lane * 2 + 1] * siluf_(zp[1]);
            *(unsigned*)(MIX + (size_t)m * 1024 + 512 + h * 128 + lane * 2) = pk2(y0, y1);
        }
    }
    SEAM(5);
    if (IN(6)) {
        PH_BEGIN const float* b_out = INP(10); bf16* WOUT_T = WSP(bf16, WS_WOUT); bf16* MIX = WSP(bf16, WS_MIX); float* H = WSP(float, WS_H);
        pg8::Gemm g{MIX, WOUT_T, 1024, 1024, 1024}; pg8::StaticOrder S; S.init(M, 1024, G, blk);
        pg8::EpiF32 E{H, 1024, b_out, nullptr};
        pg8::gemm_phase<pg8::EpiF32, pg8::StaticOrder>(L + RING_OFF, g, S, E);
    }
    SEAM(6);

    for (int layer = 0; layer < 2; ++layer) {
        const int pb = layer == 0 ? 7 : 14;
        if (layer == 1) {
            if (IN(12)) {
            PH_BEGIN float* X2 = WSP(float, WS_X2); bf16* POOLED = WSP(bf16, WS_POOLED);
                for (int m = gw; m < M; m += NGW) {
                    const int tt = m & (SEQ - 1);
#pragma unroll
                    for (int gi = 0; gi < 4; ++gi) { const int win = 2 << gi; const int cnt = tt + 1 < win ? tt + 1 : win;
                        const float* xp = X2 + (size_t)m * D + gi * 256 + lane * 4;
                        const f32x4 self = *(const GAS f32x4*)xp; f32x4 s = self;
                        for (int d = 1; d < cnt; ++d) s = s + *(const GAS f32x4*)(xp - (size_t)d * D);
                        const float ic = 1.0f / (float)cnt;
                        v2u w; w.x = pk2(s.x * ic - self.x, s.y * ic - self.y); w.y = pk2(s.z * ic - self.z, s.w * ic - self.w);
                        *(GAS v2u*)(POOLED + (size_t)m * D + gi * 256 + lane * 4) = w; }
                }
            }
            SEAM(12);
            if (IN(13)) {
            PH_BEGIN const float* pool_b = INP(12); const float* pool_scale = INP(13); bf16* POOLED = WSP(bf16, WS_POOLED); bf16* PW_T = WSP(bf16, WS_PW); float* H = WSP(float, WS_H);
                pg8::Gemm g{POOLED, PW_T, 256, 1024, 256}; pg8::PoolOrder S{G, blk};
                pg8::EpiF32 E{H, 1024, pool_b, pool_scale};
                pg8::gemm_phase<pg8::EpiF32, pg8::PoolOrder>(L + RING_OFF, g, S, E);
            }
            SEAM(13);
        }
        if (IN(pb)) {
            PH_BEGIN const float* x_in = INP(0); const float* ln1_g = INP(14); const float* ln1_b = INP(15); const float* router_w = INP(16); const float* router_b = INP(17); float* X2 = WSP(float, WS_X2); float* H = WSP(float, WS_H); float* X1 = WSP(float, WS_X1); bf16* XB = WSP(bf16, WS_XB); int* TOPI = WSP(int, WS_TOPI); float* TOPW = WSP(float, WS_TOPW); int* meta = WSP(int, WS_META);
            LAS int* hist = (LAS int*)(L); LAS float* yrow = (LAS float*)(L + 4096 + wave * 4096);
            if (tid < 32) hist[tid] = 0;
            __syncthreads();
            const float* xin = layer == 0 ? x_in : X2;
            const float* g1 = ln1_g + layer * D; const float* b1v = ln1_b + layer * D;
            const float* rw = router_w + (size_t)layer * D * NE; const float* rb = router_b + layer * NE;
            for (int it = 0; it < M / NGW; ++it) {
                const int m = it * NGW + gw;
                const GAS f32x4* xr = (const GAS f32x4*)(xin + (size_t)m * D) + lane; const GAS f32x4* hr = (const GAS f32x4*)(H + (size_t)m * D) + lane;
                f32x4 v[4]; float s = 0.f;
#pragma unroll
                for (int j = 0; j < 4; ++j) { v[j] = xr[64 * j] * ALPHA + hr[64 * j]; s += (v[j].x + v[j].y) + (v[j].z + v[j].w); }
                const float mean = wave_sum(s) * (1.f / D); float s2 = 0.f;
#pragma unroll
                for (int j = 0; j < 4; ++j) { v[j] = v[j] - mean; s2 += (v[j].x * v[j].x + v[j].y * v[j].y) + (v[j].z * v[j].z + v[j].w * v[j].w); }
                const float rstd = rsqrtf(wave_sum(s2) * (1.f / D) + LN_EPS);
#pragma unroll
                for (int j = 0; j < 4; ++j) { const int col = 256 * j + 4 * lane;
                    const f32x4 gv = *(const GAS f32x4*)(g1 + col), bv = *(const GAS f32x4*)(b1v + col);
                    v[j] = v[j] * rstd * gv + bv;
                    *((GAS f32x4*)(X1 + (size_t)m * D) + lane + 64 * j) = v[j];
                    v2u w; w.x = pk2(v[j].x, v[j].y); w.y = pk2(v[j].z, v[j].w); *((GAS v2u*)(XB + (size_t)m * D) + lane + 64 * j) = w;
                    *(LAS f32x4*)(yrow + col) = v[j]; }
                asm volatile("s_waitcnt lgkmcnt(0)" ::: "memory");
                float mine;
                { const int e = lane & 31, hh = lane >> 5; const float* rwp = rw + (size_t)(hh * 512) * NE + e; const LAS float* yp = yrow + hh * 512;
                    float a0 = 0.f, a1 = 0.f, a2 = 0.f, a3 = 0.f;
#pragma unroll 4
                    for (int c = 0; c < 512; c += 4) { const f32x4 yv = *(const LAS f32x4*)(yp + c);
                        a0 += yv.x * rwp[(size_t)c * NE]; a1 += yv.y * rwp[(size_t)(c + 1) * NE]; a2 += yv.z * rwp[(size_t)(c + 2) * NE]; a3 += yv.w * rwp[(size_t)(c + 3) * NE]; }
                    const float part = (a0 + a1) + (a2 + a3);
                    const float logit = part + __shfl_xor(part, 32) + rb[e];
                    mine = lane < 32 ? logit : -INFINITY; }
                asm volatile("s_waitcnt lgkmcnt(0)" ::: "memory");
                float tv[4]; int ti[4];
#pragma unroll
                for (int k = 0; k < 4; ++k) { float bv = mine; int bi = lane;
#pragma unroll
                    for (int o = 1; o < 64; o <<= 1) { const float ov = __shfl_xor(bv, o); const int oi = __shfl_xor(bi, o); if (ov > bv || (ov == bv && oi < bi)) { bv = ov; bi = oi; } }
                    tv[k] = bv; ti[k] = bi; if (lane == bi) mine = -INFINITY; }
                const float e1 = expf(tv[1] - tv[0]), e2 = expf(tv[2] - tv[0]), e3 = expf(tv[3] - tv[0]); const float inv = 1.0f / (1.0f + e1 + e2 + e3);
                if (lane < 4) { const int ix = lane == 0 ? ti[0] : lane == 1 ? ti[1] : lane == 2 ? ti[2] : ti[3]; const float wv = (lane == 0 ? 1.0f : lane == 1 ? e1 : lane == 2 ? e2 : e3) * inv;
                    TOPI[(size_t)m * 4 + lane] = ix; TOPW[(size_t)m * 4 + lane] = wv; atomicAdd((int*)(hist + ix), 1); }
            }
            __syncthreads();
            if (tid < 32) meta[META_BHIST + blk * 32 + tid] = hist[tid];
        }
        SEAM(pb);
        if (IN(pb + 1)) {
            PH_BEGIN bf16* XB = WSP(bf16, WS_XB); int* TOPI = WSP(int, WS_TOPI); int* TOKPOS = WSP(int, WS_TOKPOS); int* SORTED = WSP(int, WS_SORTED); bf16* XPERM = WSP(bf16, WS_XPERM); int* meta = WSP(int, WS_META);
            LAS int* hl = (LAS int*)(L); LAS int* cntL = hl + 8192; LAS int* mineL = cntL + 32; LAS int* baseL = mineL + 32; LAS int* entL = baseL + 40; LAS int* posL = entL + 256;
            for (int i = tid; i < G * 32; i += 512) hl[i] = meta[META_BHIST + i];
            if (tid < 256) { const int it = tid >> 5, w = (tid >> 2) & 7, k = tid & 3; const int m = it * NGW + blk * NWAVES + w; entL[tid] = TOPI[(size_t)m * 4 + k]; }
            __syncthreads();
            if (tid < 32) { int cnt = 0, mine = 0; for (int b = 0; b < G; ++b) { const int c = hl[b * 32 + tid]; if (b < blk) mine += c; cnt += c; } cntL[tid] = cnt; mineL[tid] = mine; }
            __syncthreads();
            if (tid == 0) { int base = 0; for (int e = 0; e < 32; ++e) { baseL[e] = base; base += (cntL[e] + 255) & ~255; } baseL[32] = base; }
            __syncthreads();
            if (tid < 32) { int off = baseL[tid] + mineL[tid]; for (int ent = 0; ent < 256; ++ent) if (entL[ent] == tid) posL[ent] = off++; }
            __syncthreads();
            if (tid < 256) { const int it = tid >> 5, w = (tid >> 2) & 7, k = tid & 3; const int m = it * NGW + blk * NWAVES + w; const int pos = posL[tid]; TOKPOS[(size_t)m * 4 + k] = pos; SORTED[pos] = m; }
            for (int en = wave * 32; en < wave * 32 + 32; ++en) { const int it = en >> 5, w = (en >> 2) & 7; const int m = it * NGW + blk * NWAVES + w; const int pos = posL[en];
                const GAS v4u* src = (const GAS v4u*)(XB + (size_t)m * D); GAS v4u* dst = (GAS v4u*)(XPERM + (size_t)pos * D);
                dst[lane] = src[lane]; dst[lane + 64] = src[lane + 64]; }
            if (blk < 32) { const int e = blk; const int r0 = baseL[e] + cntL[e], r1 = baseL[e + 1];
                for (int r = r0 + wave; r < r1; r += NWAVES) { GAS v4u* dst = (GAS v4u*)(XPERM + (size_t)r * D); const v4u z = {0u, 0u, 0u, 0u}; dst[lane] = z; dst[lane + 64] = z; if (lane == 0) SORTED[r] = -1; } }
            if (blk == 0) { if (tid < 32) { for (int pm = baseL[tid] >> 8; pm < (baseL[tid + 1] >> 8); ++pm) meta[META_TILE_E + pm] = tid; } if (tid == 0) meta[META_NTILES] = baseL[32] >> 8; }
        }
        SEAM(pb + 1);
        if (IN(pb + 2)) {
            PH_BEGIN const float* moe_b1 = INP(19); bf16* W1T = WSP(bf16, WS_W1); bf16* XPERM = WSP(bf16, WS_XPERM); bf16* ACT = WSP(bf16, WS_ACT); int* meta = WSP(int, WS_META);
            pg8::Gemm g{XPERM, W1T + (size_t)layer * NE * 2048 * 1024, 1024, 1024, 1024};
            pg8::GroupedOrder S{meta + META_TILE_E, meta[META_NTILES], 8, G, blk};
            pg8::EpiSwiGLU E{ACT, moe_b1 + (size_t)layer * NE * 2048};
            pg8::gemm_phase<pg8::EpiSwiGLU, pg8::GroupedOrder>(L + RING_OFF, g, S, E);
        }
        SEAM(pb + 2);
        if (IN(pb + 3)) {
            PH_BEGIN const float* moe_b2 = INP(21); bf16* W2T = WSP(bf16, WS_W2); bf16* ACT = WSP(bf16, WS_ACT); float* YS = WSP(float, WS_YS); int* meta = WSP(int, WS_META);
            pg8::Gemm g{ACT, W2T + (size_t)layer * NE * 1024 * 1024, 1024, 1024, 1024};
            pg8::GroupedOrder S{meta + META_TILE_E, meta[META_NTILES], 4, G, blk};
            pg8::EpiYS E{YS, moe_b2 + (size_t)layer * NE * 1024};
            pg8::gemm_phase<pg8::EpiYS, pg8::GroupedOrder>(L + RING_OFF, g, S, E);
        }
        SEAM(pb + 3);
        if (IN(pb + 4)) {
            PH_BEGIN const float* ln2_g = INP(22); const float* ln2_b = INP(23); float* X1 = WSP(float, WS_X1); float* X2 = WSP(float, WS_X2); float* YS = WSP(float, WS_YS); int* TOKPOS = WSP(int, WS_TOKPOS); float* TOPW = WSP(float, WS_TOPW); float* xout = layer == 0 ? X2 : A_->out;
            const float* g2 = ln2_g + layer * D; const float* b2v = ln2_b + layer * D;
            for (int m = gw; m < M; m += NGW) {
                f32x4 v[4];
                const GAS f32x4* xr = (const GAS f32x4*)(X1 + (size_t)m * D) + lane;
#pragma unroll
                for (int j = 0; j < 4; ++j) v[j] = xr[64 * j] * ALPHA;
#pragma unroll
                for (int k = 0; k < 4; ++k) { const int pos = TOKPOS[(size_t)m * 4 + k]; const float wv = TOPW[(size_t)m * 4 + k];
                    const GAS f32x4* yr = (const GAS f32x4*)(YS + (size_t)pos * D) + lane;
#pragma unroll
                    for (int j = 0; j < 4; ++j) v[j] = v[j] + yr[64 * j] * wv; }
                float s = 0.f;
#pragma unroll
                for (int j = 0; j < 4; ++j) s += (v[j].x + v[j].y) + (v[j].z + v[j].w);
                const float mean = wave_sum(s) * (1.f / D); float s2 = 0.f;
#pragma unroll
                for (int j = 0; j < 4; ++j) { v[j] = v[j] - mean; s2 += (v[j].x * v[j].x + v[j].y * v[j].y) + (v[j].z * v[j].z + v[j].w * v[j].w); }
                const float rstd = rsqrtf(wave_sum(s2) * (1.f / D) + LN_EPS);
#pragma unroll
                for (int j = 0; j < 4; ++j) { const int col = 256 * j + 4 * lane; const f32x4 gv = *(const GAS f32x4*)(g2 + col), bv = *(const GAS f32x4*)(b2v + col);
                    *((GAS f32x4*)(xout + (size_t)m * D) + lane + 64 * j) = v[j] * rstd * gv + bv; }
            }
        }
        if (layer == 0) SEAM(pb + 4);
    }
#undef IN
#undef SEAM
}

constexpr int N_PHASES = 19;
extern "C" void kernel_launch(void* const* d_in, const int* in_sizes, int n_in, void* d_out, int out_size, void* d_ws, size_t ws_size, hipStream_t stream) {
    static int grid = 0;
    if (grid == 0) {
        if (n_in != 24 || out_size != M * D || ws_size < WS_END) { fprintf(stderr, "kernel_launch: unexpected shapes (n_in %d, out %d, ws %zu < %zu); nothing launched\n", n_in, out_size, ws_size, (size_t)WS_END); grid = -1; return; }
        int dev = 0, cus = 0, per_cu = 0;
        if (hipGetDevice(&dev) != hipSuccess || hipDeviceGetAttribute(&cus, hipDeviceAttributeMultiprocessorCount, dev) != hipSuccess) { grid = -1; return; }
        if (hipFuncSetAttribute((const void*)hybrid_fwd, hipFuncAttributeMaxDynamicSharedMemorySize, LDS_BYTES) != hipSuccess) { fprintf(stderr, "kernel_launch: hipFuncSetAttribute failed\n"); grid = -1; return; }
        if (hipOccupancyMaxActiveBlocksPerMultiprocessor(&per_cu, (const void*)hybrid_fwd, NWAVES * 64, LDS_BYTES) != hipSuccess || per_cu < 1) { fprintf(stderr, "kernel_launch: occupancy query says %d\n", per_cu); (void)hipGetLastError(); grid = -1; return; }
        if (cus != 256) { fprintf(stderr, "kernel_launch: built for a 256-CU device, found %d\n", cus); grid = -1; return; }
        grid = cus;
    }
    if (grid < 0) return;
    (void)hipMemsetAsync((char*)d_ws + WS_CTL, 0, CTL_ZERO_BYTES, stream);
    Args a{};
    for (int i = 0; i < 24; ++i) a.in[i] = (const float*)d_in[i];
    a.out = (float*)d_out; a.ws = (unsigned char*)d_ws;
#if MK_N_LAUNCHES == 1
    a.ph_lo = 0; a.ph_hi = N_PHASES;
    hipLaunchKernelGGL(hybrid_fwd, dim3(grid), dim3(NWAVES * 64), LDS_BYTES, stream, a);
#else
#ifndef PROBE_REPEAT
#define PROBE_REPEAT 0
#endif
    for (int p = 0; p < N_PHASES; ++p) { a.ph_lo = p; a.ph_hi = p + 1; for (int r = 0; r < ((PROBE_REPEAT >> (p)) & 1 ? 5 : 1); ++r) hipLaunchKernelGGL(hybrid_fwd, dim3(grid), dim3(NWAVES * 64), LDS_BYTES, stream, a); }
#endif
}
```

```cpp
#include <hip/hip_runtime.h>
#include <cstdio>
#include <cstdint>

#ifndef MK_N_LAUNCHES
#define MK_N_LAUNCHES 1
#endif

namespace pg8 {
#define PG8_LAS __attribute__((address_space(3)))
typedef unsigned short bf16_t;
typedef short bf16x8 __attribute__((ext_vector_type(8)));
typedef float f32x4 __attribute__((ext_vector_type(4)));
typedef unsigned u32x4 __attribute__((ext_vector_type(4)));
typedef unsigned u32x2 __attribute__((ext_vector_type(2)));
constexpr int BM = 256, BK = 64, HALF = 128, HTB = HALF * BK * 2  , STAGE_BYTES = 8 * HTB, NXCD = 8, WGM = 8;

__host__ __device__ __forceinline__ int lds_byte(int r, int c) { const int st = (r >> 4) * 2 + (c >> 5), rr = r & 15, cc = c & 31, ob = rr * 64 + cc * 2; return st * 1024 + (ob ^ (((ob >> 9) & 1) << 5)); }
__host__ __device__ __forceinline__ void stage_rc(int b, int& R, int& C) { const int st = b / 1024, sb = b % 1024, swz = sb ^ (((sb >> 9) & 1) << 5); R = (st >> 1) * 16 + swz / 64; C = (st & 1) * 32 + (swz % 64) / 2; }
__host__ __device__ __forceinline__ int perm32(int rho) { const int n = rho >> 4, i = rho & 15; return 8 * (i >> 2) + 4 * n + (i & 3); }

struct Unit { int pm, pn, aoff; };
struct Gemm { const bf16_t* A; const bf16_t* Bt; int K, lda, ldb; };

struct StaticOrder {
    int nM, nN, nwg, G, c;
    __host__ __device__ void init(int M, int N, int G_, int c_) { nM = M / BM; nN = N / BM; nwg = nM * nN; G = G_; c = c_; }
    __host__ __device__ bool next(int i, Unit& u) const {
        const long L = (long)i * G + c; if (L >= nwg) return false;
        int wgid = (int)L; { const int q = nwg / NXCD, r = nwg % NXCD, xcd = wgid % NXCD, off = wgid / NXCD; wgid = (xcd < r ? xcd * (q + 1) : r * (q + 1) + (xcd - r) * q) + off; }
        const int nig = WGM * nN, gid = wgid / nig, fm = gid * WGM, gsz = (nM - fm) < WGM ? (nM - fm) : WGM;
        u.pm = fm + ((wgid % nig) % gsz); u.pn = (wgid % nig) / gsz; u.aoff = 0; return true;
    }
    static constexpr bool GATHER = false;
};
struct PoolOrder {
    int G, c;
    __device__ bool next(int i, Unit& u) const { const int L = i * G + c; if (L >= 256) return false; u.pm = L >> 2; u.pn = L & 3; u.aoff = (L & 3) * 256 * 2; return true; }
    static constexpr bool GATHER = false;
};
template <bool GATH> struct GroupedOrderT {
    static constexpr bool GATHER = GATH;
    const int* tile_e; const PG8_LAS int* tab; int ntiles, nN, G, c;
    __device__ bool next(int i, Unit& u) const {
        int pm, pnl;
        if (G == 256) { const int x = c & 7, j = c >> 3, s = i * 8 + x; if (nN == 8) { pm = 4 * s + (j >> 3); pnl = j & 7; } else { pm = 8 * s + (j >> 2); pnl = j & 3; } }
        else { const int L = i * G + c; pm = L / nN; pnl = L % nN; }
        if (pm >= ntiles) return false;
        const int e = tile_e[pm]; u.pm = pm; u.pn = e * nN + pnl; u.aoff = 0; return true;
    }
    __device__ __forceinline__ int a_row(int ui, int r) const { return tab[ui * 256 + r]; }
};

__device__ __forceinline__ unsigned cvt_pk_bf16(float lo, float hi) { unsigned r; asm volatile("v_cvt_pk_bf16_f32 %0, %1, %2" : "=v"(r) : "v"(lo), "v"(hi)); return r; }

struct EpiF32 {
    static constexpr bool PERM = false;
    float* C; int ldc; const float* bias; const float* scale;
    __device__ __forceinline__ void operator()(const f32x4 (&acc)[2][2][4][2], const Unit& u, int wr, int wc, int fr, int fq) const {
        const int row0 = u.pm * BM + wr * 64 + fr, col0 = u.pn * BM + wc * 32 + 4 * fq;
        f32x4 bv[2][2], sv[2][2];
#pragma unroll
        for (int bj = 0; bj < 2; ++bj)
#pragma unroll
            for (int n = 0; n < 2; ++n) { bv[bj][n] = bias ? *(const f32x4*)(bias + col0 + bj * HALF + n * 16) : (f32x4){0.f, 0.f, 0.f, 0.f};
                                          sv[bj][n] = scale ? *(const f32x4*)(scale + col0 + bj * HALF + n * 16) : (f32x4){1.f, 1.f, 1.f, 1.f}; }
#pragma unroll
        for (int ai = 0; ai < 2; ++ai)
#pragma unroll
            for (int m = 0; m < 4; ++m) { float* rowp = C + (size_t)(row0 + ai * HALF + m * 16) * ldc + col0;
#pragma unroll
                for (int bj = 0; bj < 2; ++bj)
#pragma unroll
                    for (int n = 0; n < 2; ++n) *(f32x4*)(rowp + bj * HALF + n * 16) = (acc[ai][bj][m][n] + bv[bj][n]) * sv[bj][n]; }
    }
};
struct EpiBf16B {
    static constexpr bool PERM = true;
    bf16_t* O; int ldc; const float* bias;
    __device__ __forceinline__ void operator()(const f32x4 (&acc)[2][2][4][2], const Unit& u, int wr, int wc, int fr, int fq) const {
        const int row0 = u.pm * BM + wr * 64 + fr, col0 = u.pn * BM + wc * 32 + 8 * fq;
        f32x4 bv[2][2];
#pragma unroll
        for (int bj = 0; bj < 2; ++bj)
#pragma unroll
            for (int n = 0; n < 2; ++n) bv[bj][n] = *(const f32x4*)(bias + col0 + bj * HALF + 4 * n);
#pragma unroll
        for (int ai = 0; ai < 2; ++ai)
#pragma unroll
            for (int m = 0; m < 4; ++m) { bf16_t* rowp = O + (size_t)(row0 + ai * HALF + m * 16) * ldc + col0;
#pragma unroll
                for (int bj = 0; bj < 2; ++bj) { const f32x4 v0 = acc[ai][bj][m][0] + bv[bj][0], v1 = acc[ai][bj][m][1] + bv[bj][1];
                    u32x4 w; w.x = cvt_pk_bf16(v0[0], v0[1]); w.y = cvt_pk_bf16(v0[2], v0[3]); w.z = cvt_pk_bf16(v1[0], v1[1]); w.w = cvt_pk_bf16(v1[2], v1[3]);
                    *(u32x4*)(rowp + bj * HALF) = w; } }
    }
};
struct EpiYS {
    static constexpr bool PERM = true;
    bf16_t* O; const float* b2;
    __device__ __forceinline__ void operator()(const f32x4 (&acc)[2][2][4][2], const Unit& u, int wr, int wc, int fr, int fq) const {
        const int e = u.pn >> 2, pnl = u.pn & 3;
        const int row0 = u.pm * BM + wr * 64 + fr, col0 = pnl * BM + wc * 32 + 8 * fq;
        const float* bias = b2 + e * 1024;
        f32x4 bv[2][2];
#pragma unroll
        for (int bj = 0; bj < 2; ++bj)
#pragma unroll
            for (int n = 0; n < 2; ++n) bv[bj][n] = *(const f32x4*)(bias + col0 + bj * HALF + 4 * n);
#pragma unroll
        for (int ai = 0; ai < 2; ++ai)
#pragma unroll
            for (int m = 0; m < 4; ++m) { bf16_t* rowp = O + (size_t)(row0 + ai * HALF + m * 16) * 1024 + col0;
#pragma unroll
                for (int bj = 0; bj < 2; ++bj) { const f32x4 v0 = acc[ai][bj][m][0] + bv[bj][0], v1 = acc[ai][bj][m][1] + bv[bj][1];
                    u32x4 w; w.x = cvt_pk_bf16(v0[0], v0[1]); w.y = cvt_pk_bf16(v0[2], v0[3]); w.z = cvt_pk_bf16(v1[0], v1[1]); w.w = cvt_pk_bf16(v1[2], v1[3]);
                    *(u32x4*)(rowp + bj * HALF) = w; } }
    }
};
struct EpiSwiGLU {
    static constexpr bool PERM = true;
    bf16_t* O; const float* b1;
    __device__ __forceinline__ void operator()(const f32x4 (&acc)[2][2][4][2], const Unit& u, int wr, int wc, int fr, int fq) const {
        const int e = u.pn >> 3, pnl = u.pn & 7;
        const int row0 = u.pm * BM + wr * 64 + fr, col0 = pnl * BM + wc * 32 + 8 * fq;
        const float* bias = b1 + e * 2048;
        f32x4 bv[2][2];
#pragma unroll
        for (int bj = 0; bj < 2; ++bj)
#pragma unroll
            for (int n = 0; n < 2; ++n) bv[bj][n] = *(const f32x4*)(bias + col0 + bj * HALF + 4 * n);
#pragma unroll
        for (int ai = 0; ai < 2; ++ai)
#pragma unroll
            for (int m = 0; m < 4; ++m) { bf16_t* rowp = O + (size_t)(row0 + ai * HALF + m * 16) * 1024 + (col0 >> 1);
#pragma unroll
                for (int bj = 0; bj < 2; ++bj) { const f32x4 v0 = acc[ai][bj][m][0] + bv[bj][0], v1 = acc[ai][bj][m][1] + bv[bj][1];
                    float g[4] = {v0[0], v0[2], v1[0], v1[2]}, l[4] = {v0[1], v0[3], v1[1], v1[3]}, a[4];
#pragma unroll
                    for (int q = 0; q < 4; ++q) { const float hg = fminf(g[q], 7.0f), hl = fminf(fmaxf(l[q], -7.0f), 7.0f);
                        a[q] = hg * (1.0f / (1.0f + __expf(-1.702f * hg))) * (hl + 1.0f); }
                    u32x2 w; w.x = cvt_pk_bf16(a[0], a[1]); w.y = cvt_pk_bf16(a[2], a[3]);
                    *(u32x2*)(rowp + bj * (HALF / 2)) = w; } }
    }
};

template <class Epi, class Sched>
__device__ __forceinline__ void gemm_phase(PG8_LAS unsigned char* lds, const Gemm g, const Sched& S, const Epi& E) {
    int tid = threadIdx.x; asm volatile("" : "+v"(tid));
    const int wid = __builtin_amdgcn_readfirstlane(tid >> 6), lane = tid & 63, wr = wid >> 2, wc = wid & 3, fr = lane & 15, fq = lane >> 4;
    int K = g.K; asm volatile("" : "+s"(K)); const int nt = K / BK;
    constexpr bool GA = Sched::GATHER;
    unsigned voffA[2], voffB[2]; int RA[2];
#pragma unroll
    for (int i = 0; i < 2; ++i) { int R, C; stage_rc(tid * 16 + i * 8192, R, C); const int Rb = Epi::PERM ? ((R & ~31) + perm32(R & 31)) : R;
        RA[i] = R; voffA[i] = GA ? (unsigned)C * 2u : (unsigned)(R * g.lda + C) * 2u; voffB[i] = (unsigned)(Rb * g.ldb + C) * 2u; }
    const size_t kstep = (size_t)(BK * 2);
    const size_t hstepA = (size_t)HALF * g.lda * 2, hstepB = (size_t)HALF * g.ldb * 2;
    const size_t tstepA = 2 * hstepA, tstepB = 2 * hstepB;
    const unsigned lda2 = (unsigned)g.lda * 2u;
#define PG8_AOFF(dst0, dst1, uidx) do { _Pragma("unroll") for (int _i = 0; _i < 2; ++_i) { dst0[_i] = (unsigned)S.a_row(uidx, RA[_i]) * lda2 + voffA[_i]; dst1[_i] = (unsigned)S.a_row(uidx, HALF + RA[_i]) * lda2 + voffA[_i]; } } while (0)
#define PG8_STAGE_A(bufoff, sbase, goffs, kb) do { if constexpr (GA) PG8_STAGE(bufoff, gA + (kb), goffs); else PG8_STAGE(bufoff, (sbase) + (kb), voffA); } while (0)
    const int aoff = lds_byte(wr * 64 + fr, fq * 8), boff = lds_byte(wc * 32 + fr, fq * 8);
    const unsigned ldsw = (unsigned)wid * 1024u;
#define PG8_SA(b, h) (((b) * 2 + (h)) * HTB)
#define PG8_SB(b, h) ((4 + (b) * 2 + (h)) * HTB)
#define PG8_STAGE(bufoff, gbase, voff) do { _Pragma("unroll") for (int _i = 0; _i < 2; ++_i) \
        __builtin_amdgcn_global_load_lds((const unsigned*)((const char*)(gbase) + (voff)[_i]), (PG8_LAS unsigned*)(lds + (bufoff) + ldsw + _i * 8192), 16, 0, 0); } while (0)
#define PG8_LDA(dst, b, h) do { _Pragma("unroll") for (int m = 0; m < 4; ++m) _Pragma("unroll") for (int k = 0; k < 2; ++k) dst[m][k] = *(const PG8_LAS bf16x8*)(lds + PG8_SA(b, h) + aoff + m * 2048 + k * 1024); } while (0)
#define PG8_LDB(dst, b, h) do { _Pragma("unroll") for (int n = 0; n < 2; ++n) _Pragma("unroll") for (int k = 0; k < 2; ++k) dst[n][k] = *(const PG8_LAS bf16x8*)(lds + PG8_SB(b, h) + boff + n * 2048 + k * 1024); } while (0)
#define PG8_MMA(ai, bj, At, Bt) do { __builtin_amdgcn_s_setprio(1); _Pragma("unroll") for (int m = 0; m < 4; ++m) _Pragma("unroll") for (int n = 0; n < 2; ++n) _Pragma("unroll") for (int k = 0; k < 2; ++k) \
        acc[ai][bj][m][n] = __builtin_amdgcn_mfma_f32_16x16x32_bf16(Bt[n][k], At[m][k], acc[ai][bj][m][n], 0, 0, 0); __builtin_amdgcn_s_setprio(0); } while (0)
#define PG8_WAIT_V(n) asm volatile("s_waitcnt vmcnt(" #n ")" ::: "memory")
#define PG8_WAIT_L(n) asm volatile("s_waitcnt lgkmcnt(" #n ")" ::: "memory")
#define PG8_BAR __builtin_amdgcn_s_barrier()
#define PG8_SCHED __builtin_amdgcn_sched_barrier(0)
    Unit cur, nxt; int ui = 0;
    if (!S.next(0, cur)) return;
    f32x4 acc[2][2][4][2];
#pragma unroll
    for (int a = 0; a < 2; ++a)
#pragma unroll
        for (int b = 0; b < 2; ++b)
#pragma unroll
            for (int m = 0; m < 4; ++m)
#pragma unroll
                for (int n = 0; n < 2; ++n) acc[a][b][m][n] = (f32x4){0.f, 0.f, 0.f, 0.f};
    bf16x8 At[4][2], B0[2][2], B1[2][2];
    unsigned cG0[2] = {0u, 0u}, cG1[2] = {0u, 0u}, nG0[2] = {0u, 0u}, nG1[2] = {0u, 0u};
    if constexpr (GA) PG8_AOFF(cG0, cG1, 0);
    const char* gA = (const char*)g.A; const char* cA = gA + (GA ? (size_t)0 : (size_t)cur.pm * tstepA + cur.aoff); const char* cB = (const char*)g.Bt + (size_t)cur.pn * tstepB;
    PG8_STAGE(PG8_SB(0, 0), cB, voffB); PG8_STAGE(PG8_SB(0, 1), cB + hstepB, voffB); PG8_STAGE_A(PG8_SA(0, 0), cA, cG0, 0); PG8_STAGE_A(PG8_SA(0, 1), cA + hstepA, cG1, 0);
    if (wr == 1) PG8_BAR;
    PG8_WAIT_V(2); PG8_BAR;
    PG8_STAGE(PG8_SB(1, 0), cB + kstep, voffB); PG8_STAGE_A(PG8_SA(1, 0), cA, cG0, kstep); PG8_STAGE(PG8_SB(1, 1), cB + hstepB + kstep, voffB);
    PG8_WAIT_V(6); PG8_BAR;
    for (;;) {
        const bool has_next = S.next(ui + 1, nxt);
        const char* nA = (has_next && !GA) ? gA + (size_t)nxt.pm * tstepA + nxt.aoff : cA; const char* nB = has_next ? (const char*)g.Bt + (size_t)nxt.pn * tstepB : cB;
        for (int t = 0; t < nt; t += 2) {
            const bool last = (t == nt - 2);
            const size_t k1 = (size_t)(t + 1) * kstep, k2 = last ? (size_t)0 : (size_t)(t + 2) * kstep, k3 = k2 + kstep;
            const char* a2 = last ? nA : cA; const char* b2 = last ? nB : cB + (size_t)(t + 2) * kstep; const char* b3 = b2 + kstep;
            if constexpr (GA) { if (last) { if (has_next) PG8_AOFF(nG0, nG1, ui + 1); else {
#pragma unroll
                        for (int _i = 0; _i < 2; ++_i) { nG0[_i] = cG0[_i]; nG1[_i] = cG1[_i]; } } } else {
#pragma unroll
                    for (int _i = 0; _i < 2; ++_i) { nG0[_i] = cG0[_i]; nG1[_i] = cG1[_i]; } } }
            PG8_LDB(B0, 0, 0); PG8_LDB(B1, 0, 1); PG8_SCHED; PG8_LDA(At, 0, 0); PG8_STAGE_A(PG8_SA(1, 1), cA + hstepA, cG1, k1);
            PG8_WAIT_V(8); PG8_WAIT_L(0); PG8_BAR; PG8_MMA(0, 0, At, B0); PG8_MMA(0, 1, At, B1); PG8_BAR; PG8_SCHED;
            PG8_LDA(At, 0, 1); PG8_STAGE(PG8_SB(0, 0), b2, voffB); PG8_STAGE(PG8_SB(0, 1), b2 + hstepB, voffB); PG8_STAGE_A(PG8_SA(0, 0), a2, nG0, k2);
            PG8_WAIT_V(8); PG8_WAIT_L(0); PG8_BAR; PG8_MMA(1, 0, At, B0); PG8_MMA(1, 1, At, B1); PG8_BAR; PG8_SCHED;
            PG8_LDB(B0, 1, 0); PG8_LDB(B1, 1, 1); PG8_SCHED; PG8_LDA(At, 1, 0); PG8_STAGE_A(PG8_SA(0, 1), a2 + hstepA, nG1, k2);
            PG8_WAIT_V(8); PG8_WAIT_L(0); PG8_BAR; PG8_MMA(0, 0, At, B0); PG8_MMA(0, 1, At, B1); PG8_BAR; PG8_SCHED;
            PG8_LDA(At, 1, 1); PG8_STAGE(PG8_SB(1, 0), b3, voffB); PG8_STAGE(PG8_SB(1, 1), b3 + hstepB, voffB); PG8_STAGE_A(PG8_SA(1, 0), a2, nG0, k3);
            PG8_WAIT_V(8); PG8_WAIT_L(0); PG8_BAR; PG8_MMA(1, 0, At, B0); PG8_MMA(1, 1, At, B1); PG8_BAR; PG8_SCHED;
        }
        if (wr == 0) PG8_BAR;
        E(acc, cur, wr, wc, fr, fq);
        if (!has_next) break;
#pragma unroll
        for (int a = 0; a < 2; ++a)
#pragma unroll
            for (int b = 0; b < 2; ++b)
#pragma unroll
                for (int m = 0; m < 4; ++m)
#pragma unroll
                    for (int n = 0; n < 2; ++n) acc[a][b][m][n] = (f32x4){0.f, 0.f, 0.f, 0.f};
        cur = nxt; cA = nA; cB = nB; ++ui;
#pragma unroll
        for (int _i = 0; _i < 2; ++_i) { cG0[_i] = nG0[_i]; cG1[_i] = nG1[_i]; }
        if (wr == 1) PG8_BAR;
    }
    PG8_WAIT_V(0);
    PG8_BAR;
#undef PG8_SA
#undef PG8_AOFF
#undef PG8_STAGE_A
#undef PG8_SB
#undef PG8_STAGE
#undef PG8_LDA
#undef PG8_LDB
#undef PG8_MMA
#undef PG8_WAIT_V
#undef PG8_WAIT_L
#undef PG8_BAR
#undef PG8_SCHED
}
}

constexpr int NWAVES = 8;
constexpr int D = 1024, SEQ = 2048, NB = 8, M = NB * SEQ;
constexpr int INW = 2824, INW_G = 2816;
constexpr int C_Q = 0, C_K = 512, C_V = 640, C_DQKV = 768, C_DZ = 2304;
constexpr int NE = 32, TOPK = 4, DE2 = 2048;
constexpr float ALPHA = 1.41421356237309515f;
constexpr float LN_EPS = 1e-5f, RMS_EPS = 1e-6f;
constexpr int MPAD_MAX = M * TOPK + NE * 256;

constexpr size_t MiB = 1u << 20;
constexpr size_t WS_CTL = 0, CTL_ZERO_BYTES = 1 * MiB;
constexpr size_t WS_META = 1 * MiB;
constexpr size_t WS_WIN = 2 * MiB, WS_WOUT = 8 * MiB, WS_PW = 10 * MiB;
constexpr size_t WS_W1 = 16 * MiB, WS_W2 = 272 * MiB;
constexpr size_t WS_XB = 400 * MiB;
constexpr size_t WS_DAB = 432 * MiB;
constexpr size_t WS_G = 433 * MiB, WS_BETA = 434 * MiB;
constexpr size_t WS_TOPI = 435 * MiB, WS_TOPW = 436 * MiB, WS_TOKPOS = 437 * MiB, WS_SORTED = 438 * MiB;
constexpr size_t WS_MIX = 440 * MiB;
constexpr size_t WS_H = 472 * MiB;
constexpr size_t WS_X1 = 536 * MiB, WS_X2 = 600 * MiB;
constexpr size_t WS_POOLED = 664 * MiB;
constexpr size_t WS_SCR = 696 * MiB;
constexpr size_t WS_PROJ = WS_SCR;
constexpr size_t WS_QB = WS_SCR + 176 * MiB, WS_KB = WS_QB + 16 * MiB, WS_VB = WS_KB + 16 * MiB;
constexpr size_t WS_OO = WS_VB + 16 * MiB;
constexpr size_t WS_DNC = WS_OO + 32 * MiB;
constexpr size_t WS_GL = WS_DNC + 72 * MiB;
constexpr size_t WS_QA = WS_GL + 1 * MiB, WS_KA = WS_QA + 16 * MiB, WS_VA = WS_KA + 4 * MiB;
constexpr int DNC_BYTES = 73728, DNC_WF = 0, DNC_QF = 16384, DNC_QKF = 32768, DNC_KDF = 40960, DNC_UF = 57344;
constexpr size_t WS_XPERM = WS_SCR;
constexpr size_t WS_ACT = WS_SCR + 144 * MiB;
constexpr size_t WS_YS = WS_SCR + 288 * MiB;
constexpr size_t WS_END = WS_SCR + 576 * MiB;
constexpr int META_BHIST = 0, META_TILE_E = 8192, META_NTILES = 8192 + 512;

constexpr int CW_BAR = 4096;
constexpr int RING_OFF = 0, RING_BYTES = 131072;
constexpr int LDSCTL_OFF = 147456, MISC_OFF = LDSCTL_OFF + 320;
constexpr int LDS_BYTES = 151552;

#define GAS __attribute__((address_space(1)))
#define LAS __attribute__((address_space(3)))
typedef unsigned short bf16;
typedef unsigned v4u __attribute__((ext_vector_type(4)));
typedef unsigned v2u __attribute__((ext_vector_type(2)));
typedef float f32x4 __attribute__((ext_vector_type(4)));
#define LDS_WAIT() asm volatile("s_waitcnt lgkmcnt(0)" ::: "memory")
__device__ __forceinline__ unsigned f2bf(float f) { unsigned u = __builtin_bit_cast(unsigned, f); return (u + 0x7fffu + ((u >> 16) & 1u)) >> 16; }
__device__ __forceinline__ unsigned pk2(float lo, float hi) { return f2bf(lo) | (f2bf(hi) << 16); }

#define XB_TMO      128
#define XB_XCNT(j)  (256  + 64 * (j))
#define XB_XSUB(j)  (1280 + 64 * (j))
#define XB_XGEN(j)  (2304 + 64 * (j))
#define XB_TOP      3328
#define XB_TOPGEN   3392
#define XCD_BAR_WORDS 3456
#define XB_SPIN_CAP (1u << 18)
__device__ __forceinline__ unsigned xb_ld(unsigned* p)              { return __hip_atomic_load(p, __ATOMIC_RELAXED, __HIP_MEMORY_SCOPE_AGENT); }
__device__ __forceinline__ unsigned xb_add(unsigned* p, unsigned v) { return __hip_atomic_fetch_add(p, v, __ATOMIC_RELAXED, __HIP_MEMORY_SCOPE_AGENT); }
__device__ __forceinline__ unsigned xb_xcc_id() { return (unsigned)__builtin_amdgcn_s_getreg((3 << 11) | 20) & 0xFu; }
#define XB_SPIN(cond, bar) do { unsigned _sp = 0; while (cond) { __builtin_amdgcn_s_sleep(1); \
    if ((++_sp & 255u) == 0u) { if (xb_ld(&(bar)[XB_TMO])) break; if (_sp > XB_SPIN_CAP) { atomicAdd(&(bar)[XB_TMO], 1u); break; } } } } while (0)
struct XcdBarrier { unsigned* bar; unsigned x; volatile LAS unsigned* st; };
__device__ __forceinline__ XcdBarrier xcd_barrier_post(unsigned* bar, volatile LAS unsigned* st) {
    XcdBarrier b; b.bar = bar; b.x = xb_xcc_id(); b.st = st;
    if (threadIdx.x == 0) (void)xb_add(&bar[XB_XCNT(b.x)], 1u);
    return b;
}
__device__ __forceinline__ void xcd_barrier_complete(unsigned* bar, unsigned x, unsigned& nloc, unsigned& nx) {
    const unsigned G = gridDim.x * gridDim.y * gridDim.z;
    unsigned sum, cnt, mine, sp = 0u;
    for (;;) {
        sum = 0u; cnt = 0u; mine = 0u;
#pragma unroll
        for (unsigned j = 0; j < 16; ++j) { const unsigned c = xb_ld(&bar[XB_XCNT(j)]); sum += c; cnt += (c > 0u) ? 1u : 0u; mine = (j == x) ? c : mine; }
        if (sum == G) break;
        __builtin_amdgcn_s_sleep(1);
        if ((++sp & 255u) == 0u) { if (xb_ld(&bar[XB_TMO])) break; if (sp > XB_SPIN_CAP) { atomicAdd(&bar[XB_TMO], 1u); break; } }
    }
    nloc = mine > 0u ? mine : 1u; nx = cnt > 0u ? cnt : 1u;
}
__device__ __forceinline__ void xcd_barrier(const XcdBarrier& b) {
    asm volatile("s_waitcnt vmcnt(0)" ::: "memory");
    __syncthreads();
    if (threadIdx.x == 0) {
        unsigned* bar = b.bar;
        __builtin_amdgcn_s_waitcnt(0);
        unsigned nloc = b.st[0], nx = b.st[1];
        if (nloc == 0u) { xcd_barrier_complete(bar, b.x, nloc, nx); b.st[0] = nloc; b.st[1] = nx; }
        const unsigned old = xb_add(&bar[XB_XSUB(b.x)], 1u);
        const unsigned gen = old / nloc;
        if (old + 1u == (gen + 1u) * nloc) {
            __builtin_amdgcn_fence(__ATOMIC_RELEASE, "agent");
            asm volatile("s_waitcnt vmcnt(0)" ::: "memory");
            const unsigned og = xb_add(&bar[XB_TOP], 1u);
            const unsigned tg = og / nx;
            if (og + 1u == (tg + 1u) * nx) xb_add(&bar[XB_TOPGEN], 1u);
            else XB_SPIN(xb_ld(&bar[XB_TOPGEN]) == tg, bar);
            __builtin_amdgcn_fence(__ATOMIC_ACQUIRE, "agent");
            xb_add(&bar[XB_XGEN(b.x)], 1u);
            asm volatile("s_waitcnt vmcnt(0)" ::: "memory");
        } else {
            XB_SPIN(xb_ld(&bar[XB_XGEN(b.x)]) == gen, bar);
            __builtin_amdgcn_fence(__ATOMIC_ACQUIRE, "agent");
            asm volatile("s_waitcnt vmcnt(0)" ::: "memory");
        }
    }
    __syncthreads();
}

__device__ __forceinline__ float wave_sum(float v) {
#pragma unroll
    for (int o = 1; o < 64; o <<= 1) v += __shfl_xor(v, o);
    return v;
}
__device__ __forceinline__ float wave_max(float v) {
#pragma unroll
    for (int o = 1; o < 64; o <<= 1) v = fmaxf(v, __shfl_xor(v, o));
    return v;
}
__device__ __forceinline__ float sigmoidf_(float x) { return 1.0f / (1.0f + expf(-x)); }
__device__ __forceinline__ float siluf_(float x) { return x * sigmoidf_(x); }

typedef short bf16x8v __attribute__((ext_vector_type(8)));
__device__ __forceinline__ unsigned pkbf(float a, float b) {
    typedef float f2_ __attribute__((ext_vector_type(2))); typedef __bf16 b2_ __attribute__((ext_vector_type(2)));
    f2_ v = {a, b}; b2_ r = __builtin_convertvector(v, b2_); return __builtin_bit_cast(unsigned, r);
}
__device__ __forceinline__ bf16x8v pack8(const f32x4& a, const f32x4& b) { v4u w; w.x = pkbf(a.x, a.y); w.y = pkbf(a.z, a.w); w.z = pkbf(b.x, b.y); w.w = pkbf(b.z, b.w); return __builtin_bit_cast(bf16x8v, w); }
__device__ __forceinline__ float bflo(unsigned w) { return __builtin_bit_cast(float, w << 16); }
__device__ __forceinline__ float bfhi(unsigned w) { return __builtin_bit_cast(float, w & 0xffff0000u); }
__device__ __forceinline__ void tr_read2(unsigned a0, unsigned a1, v2u& r0, v2u& r1) {
    asm volatile("ds_read_b64_tr_b16 %0, %2\n\tds_read_b64_tr_b16 %1, %3\n\ts_waitcnt lgkmcnt(0)" : "=&v"(r0), "=&v"(r1) : "v"(a0), "v"(a1) : "memory");
}
template <int OFF> __device__ __forceinline__ void tr_read10(unsigned base, v2u (&r)[10]) {
    asm volatile("ds_read_b64_tr_b16 %0, %10 offset:%11\n\tds_read_b64_tr_b16 %1, %10 offset:%12\n\tds_read_b64_tr_b16 %2, %10 offset:%13\n\tds_read_b64_tr_b16 %3, %10 offset:%14\n\t"
                 "ds_read_b64_tr_b16 %4, %10 offset:%15\n\tds_read_b64_tr_b16 %5, %10 offset:%16\n\tds_read_b64_tr_b16 %6, %10 offset:%17\n\tds_read_b64_tr_b16 %7, %10 offset:%18\n\t"
                 "ds_read_b64_tr_b16 %8, %10 offset:%19\n\tds_read_b64_tr_b16 %9, %10 offset:%20\n\ts_waitcnt lgkmcnt(0)"
                 : "=&v"(r[0]), "=&v"(r[1]), "=&v"(r[2]), "=&v"(r[3]), "=&v"(r[4]), "=&v"(r[5]), "=&v"(r[6]), "=&v"(r[7]), "=&v"(r[8]), "=&v"(r[9])
                 : "v"(base), "i"(OFF), "i"(OFF + 2304), "i"(OFF + 4608), "i"(OFF + 4608 + 2304), "i"(OFF + 9216), "i"(OFF + 9216 + 2304), "i"(OFF + 13824), "i"(OFF + 13824 + 2304), "i"(OFF + 18432), "i"(OFF + 18432 + 2304)
                 : "memory");
}
#define MFMA16(a, b, c) __builtin_amdgcn_mfma_f32_16x16x32_bf16((a), (b), (c), 0, 0, 0)

__device__ __forceinline__ void p0_item64(const float* W, int K, int ldw, int nblk, bf16* WT, LAS unsigned char* tile, unsigned tile_addr, int item, int lane) {
    const int kb = item / nblk, nb = item % nblk, k0 = 64 * kb, n0 = 64 * nb;
    const int c16 = lane & 15, r4 = lane >> 4;
    f32x4 v[16];
#pragma unroll
    for (int i = 0; i < 16; ++i) v[i] = *(const GAS f32x4*)(W + (size_t)(k0 + 4 * i + r4) * ldw + n0 + 4 * c16);
#pragma unroll
    for (int i = 0; i < 16; ++i) { v2u w; w.x = pkbf(v[i].x, v[i].y); w.y = pkbf(v[i].z, v[i].w); *(LAS v2u*)(tile + (4 * i + r4) * 144 + c16 * 8) = w; }
    LDS_WAIT(); asm volatile("" ::: "memory");
#pragma unroll
    for (int q = 0; q < 4; ++q)
#pragma unroll
        for (int kr = 0; kr < 2; ++kr) { v2u r0, r1; const unsigned ad = tile_addr + (32 * kr + 8 * r4 + (c16 >> 2)) * 144 + (16 * q + 4 * (c16 & 3)) * 2;
            tr_read2(ad, ad + 4 * 144, r0, r1);
            v4u o; o.x = r0.x; o.y = r0.y; o.z = r1.x; o.w = r1.y;
            *(GAS v4u*)(WT + (size_t)(n0 + 16 * q + c16) * K + k0 + 32 * kr + 8 * r4) = o; }
}

struct Args { const float* in[24]; float* out; unsigned char* ws; int ph_lo, ph_hi; };

typedef const __attribute__((address_space(4))) Args CArgs;
__device__ __forceinline__ CArgs* kargs() { CArgs* p = (CArgs*)__builtin_amdgcn_kernarg_segment_ptr(); asm volatile("" : "+s"(p)); return p; }
#define PH_BEGIN CArgs* A_ = kargs(); unsigned char* ws = A_->ws; (void)ws; int tid_l_ = threadIdx.x; asm volatile("" : "+v"(tid_l_)); const int tid = tid_l_, lane = tid_l_ & 63; (void)tid; (void)lane;
#define INP(i) (A_->in[i])
#define WSP(T, off) ((T*)(ws + (off)))
__global__ void __launch_bounds__(NWAVES * 64, 2) hybrid_fwd(Args args) {
    extern __shared__ __attribute__((aligned(16))) unsigned char lds[];
    LAS unsigned char* L = (LAS unsigned char*)lds;
    volatile LAS unsigned* MISC = (volatile LAS unsigned*)(L + MISC_OFF);
    const int tid = threadIdx.x, lane = tid & 63, wave = __builtin_amdgcn_readfirstlane(tid >> 6);
    const int G = gridDim.x, blk = blockIdx.x;
    const int gw = blk * NWAVES + wave, NGW = G * NWAVES;
    unsigned* ctl = (unsigned*)(args.ws + WS_CTL);
    for (int u = tid; u < (LDS_BYTES - LDSCTL_OFF) / 4; u += NWAVES * 64) ((LAS unsigned*)(L + LDSCTL_OFF))[u] = 0u;
    __syncthreads();
    XcdBarrier bar; bar.bar = ctl + CW_BAR; bar.x = 0; bar.st = nullptr;
    if (MK_N_LAUNCHES == 1) bar = xcd_barrier_post(ctl + CW_BAR, MISC + 8);
    const int lo = args.ph_lo, hi = args.ph_hi;
#ifndef PH_MASK
#define PH_MASK 0xFFFFFFFFu
#endif
#define IN(k) (lo <= (k) && (k) < hi && ((PH_MASK >> ((k) > 13 ? (k) - 7 : (k))) & 1u))
#define SEAM(k) do { if (IN(k) && IN((k) + 1)) xcd_barrier(bar); } while (0)

    if (IN(0)) {
        PH_BEGIN const float* x_in = INP(0); const float* w_in = INP(2); const float* b_in = INP(3); const float* w_out = INP(9); const float* pool_w = INP(11); const float* moe_w1 = INP(18); const float* moe_w2 = INP(20); bf16* WIN_T = WSP(bf16, WS_WIN); bf16* WOUT_T = WSP(bf16, WS_WOUT); bf16* PW_T = WSP(bf16, WS_PW); bf16* W1T = WSP(bf16, WS_W1); bf16* W2T = WSP(bf16, WS_W2); bf16* XB = WSP(bf16, WS_XB); float* DAB = WSP(float, WS_DAB);
        LAS unsigned char* tile = L + RING_OFF + wave * 9216; const unsigned tile_addr = (unsigned)(size_t)tile;
        constexpr int I_IN = 16 * 44, I_OUT = 16 * 16, I_PW = 4 * 4;
        constexpr int S1 = I_IN, S2 = S1 + I_OUT, S3 = S2 + 4 * I_PW;
        for (int it = gw; it < S3; it += NGW) {
            if (it < S1) p0_item64(w_in, 1024, INW, 44, WIN_T, tile, tile_addr, it, lane);
            else if (it < S2) p0_item64(w_out, 1024, 1024, 16, WOUT_T, tile, tile_addr, it - S1, lane);
            else { const int r = it - S2, g = r / I_PW; p0_item64(pool_w + (size_t)g * 65536, 256, 256, 4, PW_T + (size_t)g * 65536, tile, tile_addr, r % I_PW, lane); }
        }
        __syncthreads();
        {
            constexpr int TPB = 1040; constexpr int NI1 = 64 * 64, NI = NI1 + 64 * 32;
            const unsigned tb = (unsigned)(size_t)L;
            for (int I = blk; I < NI; I += G) {
                const float* W; bf16* WT; int ldw, kb, nb;
                if (I < NI1) { const int mt = I >> 6, r = I & 63; W = moe_w1 + (size_t)mt * 2097152; WT = W1T + (size_t)mt * 2097152; ldw = 2048; kb = r >> 2; nb = r & 3; }
                else { const int J = I - NI1, mt = J >> 5, r = J & 31; W = moe_w2 + (size_t)mt * 1048576; WT = W2T + (size_t)mt * 1048576; ldw = 1024; kb = r >> 1; nb = r & 1; }
                const int k0 = 64 * kb, n0 = 512 * nb;
                f32x4 v[16];
#pragma unroll
                for (int i = 0; i < 16; ++i) v[i] = *(const GAS f32x4*)(W + (size_t)(k0 + 8 * wave + (i >> 1)) * ldw + n0 + 256 * (i & 1) + 4 * lane);
#pragma unroll
                for (int i = 0; i < 16; ++i) { v2u w; w.x = pkbf(v[i].x, v[i].y); w.y = pkbf(v[i].z, v[i].w); *(LAS v2u*)(L + (8 * wave + (i >> 1)) * TPB + (256 * (i & 1) + 4 * lane) * 2) = w; }
                __syncthreads();
                const int c16 = lane & 15, r4 = lane >> 4;
#pragma unroll
                for (int q = 0; q < 4; ++q)
#pragma unroll
                    for (int kr = 0; kr < 2; ++kr) { v2u r0, r1; const unsigned ad = tb + (32 * kr + 8 * r4 + (c16 >> 2)) * TPB + (64 * wave + 16 * q + 4 * (c16 & 3)) * 2;
                        tr_read2(ad, ad + 4 * TPB, r0, r1);
                        v4u o; o.x = r0.x; o.y = r0.y; o.z = r1.x; o.w = r1.y;
                        *(GAS v4u*)(WT + (size_t)(n0 + 64 * wave + 16 * q + c16) * 1024 + k0 + 32 * kr + 8 * r4) = o; }
                __syncthreads();
            }
        }
        {
            LAS float* wl = (LAS float*)L;
            for (int r = tid; r < 1024; r += 512) { const f32x4 a = *(const GAS f32x4*)(w_in + (size_t)r * INW + INW_G), b = *(const GAS f32x4*)(w_in + (size_t)r * INW + INW_G + 4);
                *(LAS f32x4*)(wl + r * 8) = a; *(LAS f32x4*)(wl + r * 8 + 4) = b; }
            __syncthreads();
            for (int m = gw; m < M; m += NGW) {
                const GAS f32x4* xr = (const GAS f32x4*)(x_in + (size_t)m * D) + lane;
                GAS v2u* o8 = (GAS v2u*)(XB + (size_t)m * D) + lane;
                float acc8[8];
#pragma unroll
                for (int q = 0; q < 8; ++q) acc8[q] = 0.f;
#pragma unroll
                for (int j = 0; j < 4; ++j) { const f32x4 v = xr[64 * j]; v2u w; w.x = pkbf(v.x, v.y); w.y = pkbf(v.z, v.w); o8[64 * j] = w;
#pragma unroll
                    for (int c = 0; c < 4; ++c) { const int col = 256 * j + 4 * lane + c; const float xv = v[c];
                        const f32x4 wa = *(const LAS f32x4*)(wl + col * 8), wb = *(const LAS f32x4*)(wl + col * 8 + 4);
                        acc8[0] += xv * wa.x; acc8[1] += xv * wa.y; acc8[2] += xv * wa.z; acc8[3] += xv * wa.w;
                        acc8[4] += xv * wb.x; acc8[5] += xv * wb.y; acc8[6] += xv * wb.z; acc8[7] += xv * wb.w; } }
#pragma unroll
                for (int q = 0; q < 8; ++q) acc8[q] = wave_sum(acc8[q]);
                if (lane < 8) { float r = 0.f;
#pragma unroll
                    for (int q = 0; q < 8; ++q) r = (lane == q) ? acc8[q] : r;
                    DAB[(size_t)m * 8 + lane] = r + b_in[INW_G + lane]; }
            }
        }
    }
    SEAM(0);
    if (IN(1)) {
        PH_BEGIN const float* b_in = INP(3); bf16* WIN_T = WSP(bf16, WS_WIN); bf16* XB = WSP(bf16, WS_XB); bf16* PROJ = WSP(bf16, WS_PROJ);
        pg8::Gemm g{XB, WIN_T, 1024, 1024, 1024}; pg8::StaticOrder S; S.init(M, INW_G, G, blk);
        pg8::EpiBf16B E{PROJ, INW_G, b_in};
        pg8::gemm_phase<pg8::EpiBf16B, pg8::StaticOrder>(L + RING_OFF, g, S, E);
    }
    SEAM(1);
    if (IN(2)) {
        PH_BEGIN const int* positions = (const int*)INP(1); const float* conv_w = INP(4); const float* a_log = INP(5); const float* dt_bias = INP(6); bf16* PROJ = WSP(bf16, WS_PROJ); bf16* QB = WSP(bf16, WS_QB); bf16* KB = WSP(bf16, WS_KB); bf16* VB = WSP(bf16, WS_VB); float* DAB = WSP(float, WS_DAB); float* GG = WSP(float, WS_G); float* BETA = WSP(float, WS_BETA); bf16* QA = WSP(bf16, WS_QA); bf16* KA = WSP(bf16, WS_KA); bf16* VA = WSP(bf16, WS_VA);
        for (int m = gw; m < M; m += NGW) {
            const float pos = (float)positions[m];
            const float invf[8] = {1.0f, 0.19392274f, 0.03760603f, 0.0072926646f, 0.0014142136f, 0.0002742482f, 5.3182957e-05f, 1.0313385e-05f};
            float cs[8], sn[8];
#pragma unroll
            for (int i = 0; i < 8; ++i) { const float ang = pos * invf[i]; cs[i] = __cosf(ang); sn[i] = __sinf(ang); }
            const bf16* row = PROJ + (size_t)m * INW_G;
            const int sub = lane & 7;
#pragma unroll
            for (int part = 0; part < 3; ++part) {
                const int cbase = part == 0 ? C_Q : part == 1 ? C_K : C_V;
                float v[8];
                if (part == 0 || lane < 16) { const v4u a = *(const GAS v4u*)(row + cbase + lane * 8);
                    v[0] = bflo(a.x); v[1] = bfhi(a.x); v[2] = bflo(a.y); v[3] = bfhi(a.y); v[4] = bflo(a.z); v[5] = bfhi(a.z); v[6] = bflo(a.w); v[7] = bfhi(a.w); }
                else {
#pragma unroll
                    for (int i = 0; i < 8; ++i) v[i] = 0.f; }
                if (part < 2) {
#pragma unroll
                    for (int i = 0; i < 8; ++i) { const float o = __shfl_xor(v[i], 1);
                        if (sub == 0) v[i] = v[i] * cs[i] - o * sn[i]; else if (sub == 1) v[i] = v[i] * cs[i] + o * sn[i]; }
                }
                const float sc = part == 0 ? 0.125f : 1.0f;
                v4u w; w.x = pk2(v[0] * sc, v[1] * sc); w.y = pk2(v[2] * sc, v[3] * sc); w.z = pk2(v[4] * sc, v[5] * sc); w.w = pk2(v[6] * sc, v[7] * sc);
                if (part == 0) *(GAS v4u*)(QA + (size_t)m * 512 + lane * 8) = w;
                else if (lane < 16) *(GAS v4u*)((part == 1 ? KA : VA) + (size_t)m * 128 + lane * 8) = w;
            }
        }
        for (int m = gw; m < M; m += NGW) {
            const int tt = m & (SEQ - 1);
            f32x4 acc[6];
#pragma unroll
            for (int f = 0; f < 6; ++f) acc[f] = (f32x4){0.f, 0.f, 0.f, 0.f};
#pragma unroll
            for (int j = 0; j < 4; ++j) { const int dt = 3 - j;
                if (tt - dt >= 0) { const bf16* pr = PROJ + (size_t)(m - dt) * INW_G + C_DQKV + lane * 4; const float* cw = conv_w + j * 1536 + lane * 4;
#pragma unroll
                    for (int f = 0; f < 6; ++f) { const v2u xv = *(const GAS v2u*)(pr + f * 256); acc[f] = acc[f] + *(const GAS f32x4*)(cw + f * 256) * (f32x4){bflo(xv.x), bfhi(xv.x), bflo(xv.y), bfhi(xv.y)}; } } }
#pragma unroll
            for (int f = 0; f < 6; ++f) {
                f32x4 y; y.x = siluf_(acc[f].x); y.y = siluf_(acc[f].y); y.z = siluf_(acc[f].z); y.w = siluf_(acc[f].w);
                float sc = 1.0f;
                if (f < 4) { float ss = (y.x * y.x + y.y * y.y) + (y.z * y.z + y.w * y.w);
#pragma unroll
                    for (int o = 1; o < 32; o <<= 1) ss += __shfl_xor(ss, o);
                    sc = rsqrtf(ss + RMS_EPS) * (f < 2 ? 0.08838834764831845f : 1.0f); }
                v2u w; w.x = pkbf(y.x * sc, y.y * sc); w.y = pkbf(y.z * sc, y.w * sc);
                bf16* dst = (f < 2 ? QB : f < 4 ? KB : VB) + ((size_t)m * 4 + 2 * (f & 1) + (lane >> 5)) * 128 + 4 * (lane & 31);
                *(GAS v2u*)dst = w; }
            if (lane < 4) { const int h = lane; const float da = DAB[(size_t)m * 8 + h], db = DAB[(size_t)m * 8 + 4 + h];
                const float xx = da + dt_bias[h]; const float sp = xx > 20.f ? xx : log1pf(expf(xx));
                GG[(size_t)m * 4 + h] = -expf(a_log[h]) * sp; BETA[(size_t)m * 4 + h] = sigmoidf_(db); }
        }
    }
    SEAM(2);
    if (IN(3)) {
        PH_BEGIN const float* sinks = INP(8); bf16* PROJ = WSP(bf16, WS_PROJ); bf16* QB = WSP(bf16, WS_QB); bf16* KB = WSP(bf16, WS_KB); bf16* VB = WSP(bf16, WS_VB); float* GG = WSP(float, WS_G); float* BETA = WSP(float, WS_BETA); bf16* MIX = WSP(bf16, WS_MIX); unsigned char* DNC = WSP(unsigned char, WS_DNC); float* GLB = WSP(float, WS_GL);
        {
            constexpr int KP = 272, TP = 144, AP = 68;
            constexpr int O_K = 0, O_V = 17408, O_A = 34816, O_TU = 52224, O_TW = 61440, O_GC = 70656, O_BT = 70912;
            LAS unsigned char* Kimg = L + O_K; LAS unsigned char* Vimg = L + O_V; LAS float* Amat = (LAS float*)(L + O_A);
            LAS unsigned char* Tuimg = L + O_TU; LAS unsigned char* Twimg = L + O_TW; LAS float* gcL = (LAS float*)(L + O_GC); LAS float* btL = (LAS float*)(L + O_BT);
            const unsigned lbase = (unsigned)(size_t)L;
            const int x = lane & 15, g = lane >> 4;
            for (int u = blk; u < 1024; u += G) {
                const int bh = u >> 5, c = u & 31, h = bh & 3; const size_t row0 = (size_t)(bh >> 2) * SEQ + c * 64;
                unsigned char* dn = DNC + (size_t)u * DNC_BYTES;
#pragma unroll
                for (int i = 0; i < 2; ++i) { const int piece = tid + 512 * i, row = piece >> 4, sg = piece & 15;
                    const size_t so = ((row0 + row) * 4 + h) * 128 + sg * 8;
                    *(LAS v4u*)(Kimg + row * KP + sg * 16) = *(const GAS v4u*)(KB + so); *(LAS v4u*)(Vimg + row * KP + sg * 16) = *(const GAS v4u*)(VB + so); }
                if (wave == 0) { float v = GG[(row0 + lane) * 4 + h];
#pragma unroll
                    for (int o = 1; o < 64; o <<= 1) { const float t = __shfl_up(v, o); if (lane >= o) v += t; }
                    gcL[lane] = v; btL[lane] = BETA[(row0 + lane) * 4 + h]; }
                __syncthreads();
                {
                    const int it = wave >> 1, ks2 = wave & 1;
                    f32x4 akk[2], aqk[2];
#pragma unroll
                    for (int t2 = 0; t2 < 2; ++t2) { akk[t2] = (f32x4){0.f, 0.f, 0.f, 0.f}; aqk[t2] = (f32x4){0.f, 0.f, 0.f, 0.f}; }
#pragma unroll
                    for (int ks = 0; ks < 4; ++ks) {
                        const bf16x8v ki = *(const LAS bf16x8v*)(Kimg + (16 * it + x) * KP + (32 * ks + 8 * g) * 2);
                        const bf16x8v qi = *(const GAS bf16x8v*)(QB + ((row0 + 16 * it + x) * 4 + h) * 128 + 32 * ks + 8 * g);
#pragma unroll
                        for (int t2 = 0; t2 < 2; ++t2) { const bf16x8v kj = *(const LAS bf16x8v*)(Kimg + (16 * (2 * ks2 + t2) + x) * KP + (32 * ks + 8 * g) * 2);
                            akk[t2] = MFMA16(kj, ki, akk[t2]); aqk[t2] = MFMA16(kj, qi, aqk[t2]); }
                    }
                    const int i = 16 * it + x; const float gci = gcL[i], bi = btL[i];
                    f32x4 e[2];
#pragma unroll
                    for (int t2 = 0; t2 < 2; ++t2) { const int j0 = 16 * (2 * ks2 + t2) + 4 * g; const f32x4 gcj = *(const LAS f32x4*)(gcL + j0); f32x4 av;
#pragma unroll
                        for (int r = 0; r < 4; ++r) { const int j = j0 + r; const float dec = (j <= i) ? __expf(gci - gcj[r]) : 0.f;
                            av[r] = (j < i) ? bi * akk[t2][r] * dec : 0.f; e[t2][r] = aqk[t2][r] * dec; }
                        *(LAS f32x4*)(Amat + i * AP + j0) = av; }
                    *(GAS bf16x8v*)(dn + DNC_QKF + ((it * 2 + ks2) * 64 + lane) * 16) = pack8(e[0], e[1]);
                }
                __syncthreads();
                if (wave == 0) {
                    float Tc[64];
#pragma unroll
                    for (int i = 0; i < 64; ++i) Tc[i] = 0.f;
#pragma unroll
                    for (int i = 0; i < 64; ++i) { float sacc = 0.f;
#pragma unroll
                        for (int j4 = 0; j4 < (i + 3) / 4; ++j4) { const f32x4 av = *(const LAS f32x4*)(Amat + i * AP + 4 * j4);
                            sacc += av.x * Tc[4 * j4] + av.y * Tc[4 * j4 + 1] + av.z * Tc[4 * j4 + 2] + av.w * Tc[4 * j4 + 3]; }
                        Tc[i] = (lane == i ? 1.f : 0.f) - sacc; }
                    const float bc = btL[lane], ec = bc * __expf(gcL[lane]);
#pragma unroll
                    for (int i = 0; i < 64; ++i) { *(LAS unsigned short*)(Tuimg + i * TP + lane * 2) = (unsigned short)f2bf(Tc[i] * bc); *(LAS unsigned short*)(Twimg + i * TP + lane * 2) = (unsigned short)f2bf(Tc[i] * ec); }
                } else {
                    const float gclast = gcL[63];
                    for (int jb = wave - 1; jb < 32; jb += 7) {
                        if (jb < 16) { const int mt = jb >> 2, ks = jb & 3; const int i = 16 * mt + x; const float sc = __expf(gcL[i]);
                            const bf16* qp = QB + ((row0 + i) * 4 + h) * 128 + 32 * ks + 4 * g;
                            const v2u p0 = *(const GAS v2u*)qp, p1 = *(const GAS v2u*)(qp + 16);
                            v4u w; w.x = pkbf(bflo(p0.x) * sc, bfhi(p0.x) * sc); w.y = pkbf(bflo(p0.y) * sc, bfhi(p0.y) * sc); w.z = pkbf(bflo(p1.x) * sc, bfhi(p1.x) * sc); w.w = pkbf(bflo(p1.y) * sc, bfhi(p1.y) * sc);
                            *(GAS v4u*)(dn + DNC_QF + ((mt * 4 + ks) * 64 + lane) * 16) = w;
                        } else { const int dt = (jb - 16) >> 1, ks2 = (jb - 16) & 1; const int q = x >> 2, p = x & 3;
                            const int j0 = 32 * ks2 + 4 * g;
                            v2u r0, r1; tr_read2(lbase + O_K + (j0 + q) * KP + (16 * dt + 4 * p) * 2, lbase + O_K + (j0 + 16 + q) * KP + (16 * dt + 4 * p) * 2, r0, r1);
                            const f32x4 g0 = *(const LAS f32x4*)(gcL + j0), g1 = *(const LAS f32x4*)(gcL + j0 + 16);
                            v4u w; w.x = pkbf(bflo(r0.x) * __expf(gclast - g0.x), bfhi(r0.x) * __expf(gclast - g0.y)); w.y = pkbf(bflo(r0.y) * __expf(gclast - g0.z), bfhi(r0.y) * __expf(gclast - g0.w));
                            w.z = pkbf(bflo(r1.x) * __expf(gclast - g1.x), bfhi(r1.x) * __expf(gclast - g1.y)); w.w = pkbf(bflo(r1.y) * __expf(gclast - g1.z), bfhi(r1.y) * __expf(gclast - g1.w));
                            *(GAS v4u*)(dn + DNC_KDF + ((dt * 2 + ks2) * 64 + lane) * 16) = w; }
                    }
                }
                __syncthreads();
                {
                    const int q = x >> 2, p = x & 3;
                    bf16x8v vf[2];
#pragma unroll
                    for (int ks2 = 0; ks2 < 2; ++ks2) { v2u r0, r1; const int j0 = 32 * ks2 + 8 * g;
                        tr_read2(lbase + O_V + (j0 + q) * KP + (16 * wave + 4 * p) * 2, lbase + O_V + (j0 + 4 + q) * KP + (16 * wave + 4 * p) * 2, r0, r1);
                        v4u w; w.x = r0.x; w.y = r0.y; w.z = r1.x; w.w = r1.y; vf[ks2] = __builtin_bit_cast(bf16x8v, w); }
#pragma unroll
                    for (int mt = 0; mt < 4; ++mt) { f32x4 acc = (f32x4){0.f, 0.f, 0.f, 0.f};
#pragma unroll
                        for (int ks2 = 0; ks2 < 2; ++ks2) { const bf16x8v tf = *(const LAS bf16x8v*)(Tuimg + (16 * mt + x) * TP + (32 * ks2 + 8 * g) * 2); acc = MFMA16(tf, vf[ks2], acc); }
                        v2u w; w.x = pkbf(acc.x, acc.y); w.y = pkbf(acc.z, acc.w);
                        *(GAS v2u*)(dn + DNC_UF + ((wave * 4 + mt) * 64 + lane) * 8) = w; }
                    const int it = wave >> 1;
                    bf16x8v twf[2];
#pragma unroll
                    for (int ks2 = 0; ks2 < 2; ++ks2) twf[ks2] = *(const LAS bf16x8v*)(Twimg + (16 * it + x) * TP + (32 * ks2 + 8 * g) * 2);
#pragma unroll
                    for (int kk2 = 0; kk2 < 2; ++kk2) { const int ks = 2 * (wave & 1) + kk2; f32x4 acc[2];
#pragma unroll
                        for (int t2 = 0; t2 < 2; ++t2) { const int dt = 2 * ks + t2; acc[t2] = (f32x4){0.f, 0.f, 0.f, 0.f};
#pragma unroll
                            for (int ks2 = 0; ks2 < 2; ++ks2) { v2u r0, r1; const int j0 = 32 * ks2 + 8 * g;
                                tr_read2(lbase + O_K + (j0 + q) * KP + (16 * dt + 4 * p) * 2, lbase + O_K + (j0 + 4 + q) * KP + (16 * dt + 4 * p) * 2, r0, r1);
                                v4u w; w.x = r0.x; w.y = r0.y; w.z = r1.x; w.w = r1.y; acc[t2] = MFMA16(__builtin_bit_cast(bf16x8v, w), twf[ks2], acc[t2]); } }
                        *(GAS bf16x8v*)(dn + DNC_WF + ((it * 4 + ks) * 64 + lane) * 16) = pack8(-acc[0], -acc[1]); }
                    if (tid == 0) GLB[u] = __expf(gcL[63]);
                }
                __syncthreads();
            }
        }
        {
            constexpr int VP = 144, O_KI = 0, O_VI = 272 * VP;
            const bf16* QA = WSP(bf16, WS_QA); const bf16* KA = WSP(bf16, WS_KA); const bf16* VA = WSP(bf16, WS_VA);
            const unsigned lbase = (unsigned)(size_t)L; const int x = lane & 15, g = lane >> 4;
            for (int u = blk; u < 256; u += G) {
                const int b = u >> 5, n = (u >> 1) & 15, kvh = u & 1;
                const long rowb = (long)b * SEQ + (long)(n - 1) * 128;
                for (int pc = tid; pc < 272 * 8; pc += 512) { const int row = pc >> 3, sg = pc & 7; v4u kv = {0u, 0u, 0u, 0u}, vv = {0u, 0u, 0u, 0u};
                    if (row < 256 && (n > 0 || row >= 128)) { const size_t so = (size_t)(rowb + row) * 128 + kvh * 64 + sg * 8; kv = *(const GAS v4u*)(KA + so); vv = *(const GAS v4u*)(VA + so); }
                    *(LAS v4u*)(L + O_KI + row * VP + sg * 16) = kv; *(LAS v4u*)(L + O_VI + row * VP + sg * 16) = vv; }
                __syncthreads();
                const int hq = kvh * 4 + (wave >> 1); const float sink = sinks[hq];
                for (int t = 0; t < 4; ++t) {
                    const int qi0 = 64 * (wave & 1) + 16 * t, ktb = qi0 >> 4, qi = qi0 + x;
                    const size_t qrow = (size_t)b * SEQ + n * 128 + qi;
                    bf16x8v qf[2];
#pragma unroll
                    for (int ks = 0; ks < 2; ++ks) qf[ks] = *(const GAS bf16x8v*)(QA + qrow * 512 + hq * 64 + 32 * ks + 8 * g);
                    f32x4 sc[10];
                    float mx = sink;
#pragma unroll
                    for (int kk = 0; kk < 9; ++kk) { f32x4 acc = (f32x4){0.f, 0.f, 0.f, 0.f};
#pragma unroll
                        for (int ks = 0; ks < 2; ++ks) { const bf16x8v kf = *(const LAS bf16x8v*)(L + O_KI + (16 * (ktb + kk) + x) * VP + (32 * ks + 8 * g) * 2); acc = MFMA16(kf, qf[ks], acc); }
#pragma unroll
                        for (int r = 0; r < 4; ++r) { const int kj = 16 * (ktb + kk) + 4 * g + r; const bool ok = (kj >= qi + 1) && (kj <= qi + 128) && (n > 0 || kj >= 128);
                            acc[r] = ok ? acc[r] : -INFINITY; mx = fmaxf(mx, acc[r]); }
                        sc[kk] = acc; }
                    mx = fmaxf(mx, __shfl_xor(mx, 16)); mx = fmaxf(mx, __shfl_xor(mx, 32));
                    float sum = 0.f;
#pragma unroll
                    for (int kk = 0; kk < 9; ++kk)
#pragma unroll
                        for (int r = 0; r < 4; ++r) { const float p = __expf(sc[kk][r] - mx); sc[kk][r] = p; sum += p; }
                    sc[9] = (f32x4){0.f, 0.f, 0.f, 0.f};
                    sum += __shfl_xor(sum, 16); sum += __shfl_xor(sum, 32);
                    const float inv = 1.0f / (sum + __expf(sink - mx));
                    bf16x8v Pb[5];
#pragma unroll
                    for (int pp = 0; pp < 5; ++pp) Pb[pp] = pack8(sc[2 * pp], sc[2 * pp + 1]);
                    const unsigned vb = lbase + O_VI + (16 * ktb + 4 * g + (x >> 2)) * VP + (4 * (x & 3)) * 2;
                    f32x4 o[4];
                    { v2u r[10]; tr_read10<0>(vb, r); o[0] = (f32x4){0.f, 0.f, 0.f, 0.f};
#pragma unroll
                      for (int pp = 0; pp < 5; ++pp) { v4u w; w.x = r[2 * pp].x; w.y = r[2 * pp].y; w.z = r[2 * pp + 1].x; w.w = r[2 * pp + 1].y; o[0] = MFMA16(__builtin_bit_cast(bf16x8v, w), Pb[pp], o[0]); } }
                    { v2u r[10]; tr_read10<32>(vb, r); o[1] = (f32x4){0.f, 0.f, 0.f, 0.f};
#pragma unroll
                      for (int pp = 0; pp < 5; ++pp) { v4u w; w.x = r[2 * pp].x; w.y = r[2 * pp].y; w.z = r[2 * pp + 1].x; w.w = r[2 * pp + 1].y; o[1] = MFMA16(__builtin_bit_cast(bf16x8v, w), Pb[pp], o[1]); } }
                    { v2u r[10]; tr_read10<64>(vb, r); o[2] = (f32x4){0.f, 0.f, 0.f, 0.f};
#pragma unroll
                      for (int pp = 0; pp < 5; ++pp) { v4u w; w.x = r[2 * pp].x; w.y = r[2 * pp].y; w.z = r[2 * pp + 1].x; w.w = r[2 * pp + 1].y; o[2] = MFMA16(__builtin_bit_cast(bf16x8v, w), Pb[pp], o[2]); } }
                    { v2u r[10]; tr_read10<96>(vb, r); o[3] = (f32x4){0.f, 0.f, 0.f, 0.f};
#pragma unroll
                      for (int pp = 0; pp < 5; ++pp) { v4u w; w.x = r[2 * pp].x; w.y = r[2 * pp].y; w.z = r[2 * pp + 1].x; w.w = r[2 * pp + 1].y; o[3] = MFMA16(__builtin_bit_cast(bf16x8v, w), Pb[pp], o[3]); } }
#pragma unroll
                    for (int dt = 0; dt < 4; ++dt) { v2u w; w.x = pkbf(o[dt].x * inv, o[dt].y * inv); w.y = pkbf(o[dt].z * inv, o[dt].w * inv);
                        *(GAS v2u*)(MIX + qrow * 1024 + hq * 64 + 16 * dt + 4 * g) = w; }
                }
                __syncthreads();
            }
        }
    }
    SEAM(3);
    if (IN(4)) {
        PH_BEGIN float* OO = WSP(float, WS_OO); unsigned char* DNC = WSP(unsigned char, WS_DNC); float* GLB = WSP(float, WS_GL);
        if (blk < 32) {
            const int h = blk & 3; const size_t row0 = (size_t)(blk >> 2) * SEQ; const int x = lane & 15, g = lane >> 4;
            const unsigned char* dn0 = DNC + (size_t)blk * 32 * DNC_BYTES;
            f32x4 S[8];
#pragma unroll
            for (int d = 0; d < 8; ++d) S[d] = (f32x4){0.f, 0.f, 0.f, 0.f};
#pragma unroll
            for (int p = 0; p < 9; ++p) __builtin_amdgcn_global_load_lds((const unsigned*)(dn0 + p * 8192 + tid * 16), (LAS unsigned*)(L + p * 8192 + wave * 1024), 16, 0, 0);
            for (int n = 0; n < 32; ++n) {
                asm volatile("s_waitcnt vmcnt(0)" ::: "memory"); __builtin_amdgcn_s_barrier(); asm volatile("" ::: "memory");
                if (n + 1 < 32) { const unsigned char* src = dn0 + (size_t)(n + 1) * DNC_BYTES; LAS unsigned char* dst = L + ((n + 1) & 1) * DNC_BYTES;
#pragma unroll
                    for (int p = 0; p < 9; ++p) __builtin_amdgcn_global_load_lds((const unsigned*)(src + p * 8192 + tid * 16), (LAS unsigned*)(dst + p * 8192 + wave * 1024), 16, 0, 0); }
                const LAS unsigned char* buf = L + (n & 1) * DNC_BYTES;
                const float gl = GLB[blk * 32 + n];
                bf16x8v Sb[4];
#pragma unroll
                for (int ks = 0; ks < 4; ++ks) Sb[ks] = pack8(S[2 * ks], S[2 * ks + 1]);
                f32x4 av[4], ao[4];
#pragma unroll
                for (int mt = 0; mt < 4; ++mt) { const v2u uw = *(const LAS v2u*)(buf + DNC_UF + ((wave * 4 + mt) * 64 + lane) * 8);
                    av[mt] = (f32x4){bflo(uw.x), bfhi(uw.x), bflo(uw.y), bfhi(uw.y)}; ao[mt] = (f32x4){0.f, 0.f, 0.f, 0.f}; }
#pragma unroll
                for (int mt = 0; mt < 4; ++mt)
#pragma unroll
                    for (int ks = 0; ks < 4; ++ks) { const bf16x8v wf = *(const LAS bf16x8v*)(buf + DNC_WF + ((mt * 4 + ks) * 64 + lane) * 16), qf = *(const LAS bf16x8v*)(buf + DNC_QF + ((mt * 4 + ks) * 64 + lane) * 16);
                        av[mt] = MFMA16(wf, Sb[ks], av[mt]); ao[mt] = MFMA16(qf, Sb[ks], ao[mt]); }
                bf16x8v Vb[2];
#pragma unroll
                for (int ks2 = 0; ks2 < 2; ++ks2) Vb[ks2] = pack8(av[2 * ks2], av[2 * ks2 + 1]);
#pragma unroll
                for (int mt = 0; mt < 4; ++mt)
#pragma unroll
                    for (int ks2 = 0; ks2 < 2; ++ks2) { const bf16x8v qkf = *(const LAS bf16x8v*)(buf + DNC_QKF + ((mt * 2 + ks2) * 64 + lane) * 16); ao[mt] = MFMA16(qkf, Vb[ks2], ao[mt]); }
#pragma unroll
                for (int d = 0; d < 8; ++d) { S[d] = S[d] * gl;
#pragma unroll
                    for (int ks2 = 0; ks2 < 2; ++ks2) { const bf16x8v kf = *(const LAS bf16x8v*)(buf + DNC_KDF + ((d * 2 + ks2) * 64 + lane) * 16); S[d] = MFMA16(kf, Vb[ks2], S[d]); } }
#pragma unroll
                for (int mt = 0; mt < 4; ++mt)
#pragma unroll
                    for (int r = 0; r < 4; ++r) OO[((row0 + 64 * n + 16 * mt + 4 * g + r) * 4 + h) * 128 + 16 * wave + x] = ao[mt][r];
            }
        }
    }
    SEAM(4);
    if (IN(5)) {
        PH_BEGIN const float* norm_w = INP(7); bf16* PROJ = WSP(bf16, WS_PROJ); float* OO = WSP(float, WS_OO); bf16* MIX = WSP(bf16, WS_MIX);
        for (int it = gw; it < M * 4; it += NGW) {
            const int m = it >> 2, h = it & 3;
            const float* op = OO + ((size_t)m * 4 + h) * 128 + lane * 2;
            const float o0 = op[0], o1 = op[1];
            const float r = rsqrtf(wave_sum(o0 * o0 + o1 * o1) * (1.0f / 128.0f) + RMS_EPS);
            const unsigned zw = *(const unsigned*)(PROJ + (size_t)m * INW_G + C_DZ + h * 128 + lane * 2);
            const float y0 = o0 * r * norm_w[lane * 2] * siluf_(bflo(zw)), y1 = o1 * r * norm_w[lane * 2 + 1] * siluf_(bfhi(zw));
            *(unsigned*)(MIX + (size_t)m * 1024 + 512 + h * 128 + lane * 2) = pk2(y0, y1);
        }
    }
    SEAM(5);
    if (IN(6)) {
        PH_BEGIN const float* b_out = INP(10); bf16* WOUT_T = WSP(bf16, WS_WOUT); bf16* MIX = WSP(bf16, WS_MIX); float* H = WSP(float, WS_H);
        pg8::Gemm g{MIX, WOUT_T, 1024, 1024, 1024}; pg8::StaticOrder S; S.init(M, 1024, G, blk);
        pg8::EpiF32 E{H, 1024, b_out, nullptr};
        pg8::gemm_phase<pg8::EpiF32, pg8::StaticOrder>(L + RING_OFF, g, S, E);
    }
    SEAM(6);

    for (int layer = 0; layer < 2; ++layer) {
        const int pb = layer == 0 ? 7 : 14;
        if (layer == 1) {
            if (IN(12)) {
            PH_BEGIN float* X2 = WSP(float, WS_X2); bf16* POOLED = WSP(bf16, WS_POOLED);
                LAS float* xt = (LAS float*)L;
                const int m0 = blk * 64, tt0 = m0 & (SEQ - 1);
#pragma unroll 1
                for (int gi_ = 0; gi_ < 4; ++gi_) { int gi = gi_; asm volatile("" : "+s"(gi)); const int win = 2 << gi; const int halo = tt0 == 0 ? 0 : win - 1;
                    __syncthreads();
                    for (int idx = tid; idx < (64 + halo) * 64; idx += 512) { const int r = idx >> 6, c4 = idx & 63;
                        *(LAS f32x4*)(xt + (15 - halo + r) * 256 + c4 * 4) = *(const GAS f32x4*)(X2 + (size_t)(m0 - halo + r) * D + gi * 256 + c4 * 4); }
                    __syncthreads();
#pragma unroll 1
                    for (int tk_ = 0; tk_ < 8; ++tk_) { int tk = tk_; asm volatile("" : "+s"(tk)); const int t = wave * 8 + tk; const int cnt = tt0 + t + 1 < win ? tt0 + t + 1 : win;
                        const f32x4 self = *(const LAS f32x4*)(xt + (15 + t) * 256 + lane * 4); f32x4 sm = self;
                        for (int d = 1; d < cnt; ++d) sm = sm + *(const LAS f32x4*)(xt + (15 + t - d) * 256 + lane * 4);
                        const float ic = 1.0f / (float)cnt;
                        v2u w; w.x = pkbf(sm.x * ic - self.x, sm.y * ic - self.y); w.y = pkbf(sm.z * ic - self.z, sm.w * ic - self.w);
                        *(GAS v2u*)(POOLED + (size_t)(m0 + t) * D + gi * 256 + lane * 4) = w; }
                }
            }
            SEAM(12);
            if (IN(13)) {
            PH_BEGIN const float* pool_b = INP(12); const float* pool_scale = INP(13); bf16* POOLED = WSP(bf16, WS_POOLED); bf16* PW_T = WSP(bf16, WS_PW); float* H = WSP(float, WS_H);
                pg8::Gemm g{POOLED, PW_T, 256, 1024, 256}; pg8::PoolOrder S{G, blk};
                pg8::EpiF32 E{H, 1024, pool_b, pool_scale};
                pg8::gemm_phase<pg8::EpiF32, pg8::PoolOrder>(L + RING_OFF, g, S, E);
            }
            SEAM(13);
        }
        if (IN(pb)) {
            PH_BEGIN const float* x_in = INP(0); const float* ln1_g = INP(14); const float* ln1_b = INP(15); const float* router_w = INP(16); const float* router_b = INP(17); float* X2 = WSP(float, WS_X2); float* H = WSP(float, WS_H); float* X1 = WSP(float, WS_X1); bf16* XB = WSP(bf16, WS_XB); int* TOPI = WSP(int, WS_TOPI); float* TOPW = WSP(float, WS_TOPW); int* meta = WSP(int, WS_META);
            constexpr int YP = 1028;
            LAS float* ytile = (LAS float*)(L); LAS float* part = (LAS float*)(L + 16 * YP * 4); LAS float* logitL = part + 8 * 16 * 32; LAS int* hist = (LAS int*)(logitL + 16 * 32);
            if (tid < 32) hist[tid] = 0;
            const float* xin = layer == 0 ? x_in : X2;
            const float* g1 = ln1_g + layer * D; const float* b1v = ln1_b + layer * D;
            const float* rw = router_w + (size_t)layer * D * NE; const float* rb = router_b + layer * NE;
            const int j16 = lane & 15, kq = lane >> 4;
            typedef float f32x2_ __attribute__((ext_vector_type(2)));
            f32x2_ bw[8][4];
#pragma unroll
            for (int S_ = 0; S_ < 8; ++S_)
#pragma unroll
                for (int t = 0; t < 4; ++t) bw[S_][t] = *(const GAS f32x2_*)(rw + (size_t)(128 * wave + 16 * S_ + 4 * kq + t) * NE + 2 * j16);
            __syncthreads();
            for (int I = 0; I < 4; ++I) {
#pragma unroll
                for (int half = 0; half < 2; ++half) {
                    const int ti = wave + 8 * half; const int m = (2 * I + half) * NGW + blk * NWAVES + wave;
                    const GAS f32x4* xr = (const GAS f32x4*)(xin + (size_t)m * D) + lane; const GAS f32x4* hr = (const GAS f32x4*)(H + (size_t)m * D) + lane;
                    f32x4 v[4]; float s = 0.f;
#pragma unroll
                    for (int j = 0; j < 4; ++j) { v[j] = xr[64 * j] * ALPHA + hr[64 * j]; s += (v[j].x + v[j].y) + (v[j].z + v[j].w); }
                    const float mean = wave_sum(s) * (1.f / D); float s2 = 0.f;
#pragma unroll
                    for (int j = 0; j < 4; ++j) { v[j] = v[j] - mean; s2 += (v[j].x * v[j].x + v[j].y * v[j].y) + (v[j].z * v[j].z + v[j].w * v[j].w); }
                    const float rstd = rsqrtf(wave_sum(s2) * (1.f / D) + LN_EPS);
#pragma unroll
                    for (int j = 0; j < 4; ++j) { const int col = 256 * j + 4 * lane;
                        const f32x4 gv = *(const GAS f32x4*)(g1 + col), bv = *(const GAS f32x4*)(b1v + col);
                        v[j] = v[j] * rstd * gv + bv;
                        *((GAS f32x4*)(X1 + (size_t)m * D) + lane + 64 * j) = v[j];
                        v2u w; w.x = pkbf(v[j].x, v[j].y); w.y = pkbf(v[j].z, v[j].w); *((GAS v2u*)(XB + (size_t)m * D) + lane + 64 * j) = w;
                        *(LAS f32x4*)(ytile + ti * YP + col) = v[j]; }
                }
                __syncthreads();
                {
                    f32x4 a0 = (f32x4){0.f, 0.f, 0.f, 0.f}, a1 = (f32x4){0.f, 0.f, 0.f, 0.f};
#pragma unroll
                    for (int S_ = 0; S_ < 8; ++S_) { const f32x4 ya = *(const LAS f32x4*)(ytile + j16 * YP + 128 * wave + 16 * S_ + 4 * kq);
#pragma unroll
                        for (int t = 0; t < 4; ++t) { a0 = __builtin_amdgcn_mfma_f32_16x16x4f32(ya[t], bw[S_][t].x, a0, 0, 0, 0); a1 = __builtin_amdgcn_mfma_f32_16x16x4f32(ya[t], bw[S_][t].y, a1, 0, 0, 0); } }
#pragma unroll
                    for (int r = 0; r < 4; ++r) { f32x2_ pr; pr.x = a0[r]; pr.y = a1[r]; *(LAS f32x2_*)(part + ((wave * 16 + 4 * kq + r) * 32 + 2 * j16)) = pr; }
                }
                __syncthreads();
                { const int tk = tid >> 5, e = tid & 31; float sum = rb[e];
#pragma unroll
                    for (int w = 0; w < 8; ++w) sum += part[(w * 16 + tk) * 32 + e];
                    logitL[tk * 32 + e] = sum; }
                __syncthreads();
#pragma unroll
                for (int half = 0; half < 2; ++half) {
                    const int ti = wave + 8 * half; const int m = (2 * I + half) * NGW + blk * NWAVES + wave;
                    float mine = lane < 32 ? logitL[ti * 32 + (lane & 31)] : -INFINITY;
                    float tv[4]; int tix[4];
#pragma unroll
                    for (int k = 0; k < 4; ++k) { float bv = mine; int bi = lane;
#pragma unroll
                        for (int o = 1; o < 64; o <<= 1) { const float ov = __shfl_xor(bv, o); const int oi = __shfl_xor(bi, o); if (ov > bv || (ov == bv && oi < bi)) { bv = ov; bi = oi; } }
                        tv[k] = bv; tix[k] = bi; if (lane == bi) mine = -INFINITY; }
                    const float e1 = expf(tv[1] - tv[0]), e2 = expf(tv[2] - tv[0]), e3 = expf(tv[3] - tv[0]); const float inv = 1.0f / (1.0f + e1 + e2 + e3);
                    if (lane < 4) { const int ix = lane == 0 ? tix[0] : lane == 1 ? tix[1] : lane == 2 ? tix[2] : tix[3]; const float wv = (lane == 0 ? 1.0f : lane == 1 ? e1 : lane == 2 ? e2 : e3) * inv;
                        TOPI[(size_t)m * 4 + lane] = ix; TOPW[(size_t)m * 4 + lane] = wv; atomicAdd((int*)(hist + ix), 1); }
                }
            }
            __syncthreads();
            if (tid < 32) meta[META_BHIST + blk * 32 + tid] = hist[tid];
        }
        SEAM(pb);
        if (IN(pb + 1)) {
            PH_BEGIN bf16* XB = WSP(bf16, WS_XB); int* TOPI = WSP(int, WS_TOPI); int* TOKPOS = WSP(int, WS_TOKPOS); int* SORTED = WSP(int, WS_SORTED); bf16* XPERM = WSP(bf16, WS_XPERM); int* meta = WSP(int, WS_META);
            LAS int* hl = (LAS int*)(L); LAS int* cntL = hl + 8192; LAS int* mineL = cntL + 32; LAS int* baseL = mineL + 32; LAS int* entL = baseL + 40; LAS int* posL = entL + 256;
            for (int i = tid; i < G * 32; i += 512) hl[i] = meta[META_BHIST + i];
            if (tid < 256) { const int it = tid >> 5, w = (tid >> 2) & 7, k = tid & 3; const int m = it * NGW + blk * NWAVES + w; entL[tid] = TOPI[(size_t)m * 4 + k]; }
            __syncthreads();
            if (tid < 32) { int cnt = 0, mine = 0; for (int b = 0; b < G; ++b) { const int c = hl[b * 32 + tid]; if (b < blk) mine += c; cnt += c; } cntL[tid] = cnt; mineL[tid] = mine; }
            __syncthreads();
            if (tid == 0) { int base = 0; for (int e = 0; e < 32; ++e) { baseL[e] = base; base += (cntL[e] + 255) & ~255; } baseL[32] = base; }
            __syncthreads();
            if (tid < 32) { int off = baseL[tid] + mineL[tid]; for (int ent = 0; ent < 256; ++ent) if (entL[ent] == tid) posL[ent] = off++; }
            __syncthreads();
            if (tid < 256) { const int it = tid >> 5, w = (tid >> 2) & 7, k = tid & 3; const int m = it * NGW + blk * NWAVES + w; const int pos = posL[tid]; TOKPOS[(size_t)m * 4 + k] = pos; SORTED[pos] = m; }
            if (blk < 32) { const int e = blk; const int r0 = baseL[e] + cntL[e], r1 = baseL[e + 1];
                for (int r = r0 + tid; r < r1; r += 512) SORTED[r] = -1; }
            if (blk == 0) { if (tid < 32) { for (int pm = baseL[tid] >> 8; pm < (baseL[tid + 1] >> 8); ++pm) meta[META_TILE_E + pm] = tid; } if (tid == 0) meta[META_NTILES] = baseL[32] >> 8; }
        }
        SEAM(pb + 1);
        if (IN(pb + 2)) {
            PH_BEGIN const float* moe_b1 = INP(19); bf16* W1T = WSP(bf16, WS_W1); bf16* XB = WSP(bf16, WS_XB); int* SORTED = WSP(int, WS_SORTED); bf16* ACT = WSP(bf16, WS_ACT); int* meta = WSP(int, WS_META);
            pg8::Gemm g{XB, W1T + (size_t)layer * NE * 2048 * 1024, 1024, 1024, 1024};
            LAS int* tab = (LAS int*)(L + RING_BYTES);
            pg8::GroupedOrderT<true> S{meta + META_TILE_E, tab, meta[META_NTILES], 8, G, blk};
            { pg8::Unit uu; for (int i = 0; i < 16 && S.next(i, uu); ++i) if (tid < 256) { const int t = SORTED[uu.pm * 256 + tid]; tab[i * 256 + tid] = t < 0 ? 0 : t; } }
            __syncthreads();
            pg8::EpiSwiGLU E{ACT, moe_b1 + (size_t)layer * NE * 2048};
            pg8::gemm_phase<pg8::EpiSwiGLU, pg8::GroupedOrderT<true>>(L + RING_OFF, g, S, E);
        }
        SEAM(pb + 2);
        if (IN(pb + 3)) {
            PH_BEGIN const float* moe_b2 = INP(21); bf16* W2T = WSP(bf16, WS_W2); bf16* ACT = WSP(bf16, WS_ACT); bf16* YS = WSP(bf16, WS_YS); int* meta = WSP(int, WS_META);
            pg8::Gemm g{ACT, W2T + (size_t)layer * NE * 1024 * 1024, 1024, 1024, 1024};
            pg8::GroupedOrderT<false> S{meta + META_TILE_E, nullptr, meta[META_NTILES], 4, G, blk};
            pg8::EpiYS E{YS, moe_b2 + (size_t)layer * NE * 1024};
            pg8::gemm_phase<pg8::EpiYS, pg8::GroupedOrderT<false>>(L + RING_OFF, g, S, E);
        }
        SEAM(pb + 3);
        if (IN(pb + 4)) {
            PH_BEGIN const float* ln2_g = INP(22); const float* ln2_b = INP(23); float* X1 = WSP(float, WS_X1); float* X2 = WSP(float, WS_X2); bf16* YS = WSP(bf16, WS_YS); int* TOKPOS = WSP(int, WS_TOKPOS); float* TOPW = WSP(float, WS_TOPW); float* xout = layer == 0 ? X2 : A_->out;
            const float* g2 = ln2_g + layer * D; const float* b2v = ln2_b + layer * D;
            for (int m = gw; m < M; m += NGW) {
                f32x4 v[4];
#pragma unroll
                for (int jj = 0; jj < 2; ++jj) { const GAS f32x4* xr = (const GAS f32x4*)(X1 + (size_t)m * D + 512 * jj + 8 * lane); v[2 * jj] = xr[0] * ALPHA; v[2 * jj + 1] = xr[1] * ALPHA; }
#pragma unroll
                for (int k = 0; k < 4; ++k) { const int pos = TOKPOS[(size_t)m * 4 + k]; const float wv = TOPW[(size_t)m * 4 + k];
#pragma unroll
                    for (int jj = 0; jj < 2; ++jj) { const v4u y = *(const GAS v4u*)(YS + (size_t)pos * D + 512 * jj + 8 * lane);
                        v[2 * jj] = v[2 * jj] + (f32x4){bflo(y.x), bfhi(y.x), bflo(y.y), bfhi(y.y)} * wv; v[2 * jj + 1] = v[2 * jj + 1] + (f32x4){bflo(y.z), bfhi(y.z), bflo(y.w), bfhi(y.w)} * wv; } }
                float s = 0.f;
#pragma unroll
                for (int j = 0; j < 4; ++j) s += (v[j].x + v[j].y) + (v[j].z + v[j].w);
                const float mean = wave_sum(s) * (1.f / D); float s2 = 0.f;
#pragma unroll
                for (int j = 0; j < 4; ++j) { v[j] = v[j] - mean; s2 += (v[j].x * v[j].x + v[j].y * v[j].y) + (v[j].z * v[j].z + v[j].w * v[j].w); }
                const float rstd = rsqrtf(wave_sum(s2) * (1.f / D) + LN_EPS);
#pragma unroll
                for (int j = 0; j < 4; ++j) { const int col = 512 * (j >> 1) + 8 * lane + 4 * (j & 1); const f32x4 gv = *(const GAS f32x4*)(g2 + col), bv = *(const GAS f32x4*)(b2v + col);
                    *(GAS f32x4*)(xout + (size_t)m * D + col) = v[j] * rstd * gv + bv; }
            }
        }
        if (layer == 0) SEAM(pb + 4);
    }
#undef IN
#undef SEAM
}

constexpr int N_PHASES = 19;
extern "C" void kernel_launch(void* const* d_in, const int* in_sizes, int n_in, void* d_out, int out_size, void* d_ws, size_t ws_size, hipStream_t stream) {
    static int grid = 0;
    if (grid == 0) {
        if (n_in != 24 || out_size != M * D || ws_size < WS_END) { fprintf(stderr, "kernel_launch: unexpected shapes (n_in %d, out %d, ws %zu < %zu); nothing launched\n", n_in, out_size, ws_size, (size_t)WS_END); grid = -1; return; }
        int dev = 0, cus = 0, per_cu = 0;
        if (hipGetDevice(&dev) != hipSuccess || hipDeviceGetAttribute(&cus, hipDeviceAttributeMultiprocessorCount, dev) != hipSuccess) { grid = -1; return; }
        if (hipFuncSetAttribute((const void*)hybrid_fwd, hipFuncAttributeMaxDynamicSharedMemorySize, LDS_BYTES) != hipSuccess) { fprintf(stderr, "kernel_launch: hipFuncSetAttribute failed\n"); grid = -1; return; }
        if (hipOccupancyMaxActiveBlocksPerMultiprocessor(&per_cu, (const void*)hybrid_fwd, NWAVES * 64, LDS_BYTES) != hipSuccess || per_cu < 1) { fprintf(stderr, "kernel_launch: occupancy query says %d\n", per_cu); (void)hipGetLastError(); grid = -1; return; }
        if (cus != 256) { fprintf(stderr, "kernel_launch: built for a 256-CU device, found %d\n", cus); grid = -1; return; }
        grid = cus;
    }
    if (grid < 0) return;
    (void)hipMemsetAsync((char*)d_ws + WS_CTL, 0, CTL_ZERO_BYTES, stream);
    Args a{};
    for (int i = 0; i < 24; ++i) a.in[i] = (const float*)d_in[i];
    a.out = (float*)d_out; a.ws = (unsigned char*)d_ws;
#if MK_N_LAUNCHES == 1
    a.ph_lo = 0; a.ph_hi = N_PHASES;
    hipLaunchKernelGGL(hybrid_fwd, dim3(grid), dim3(NWAVES * 64), LDS_BYTES, stream, a);
#else
#ifndef PROBE_REPEAT
#define PROBE_REPEAT 0
#endif
    for (int p = 0; p < N_PHASES; ++p) { a.ph_lo = p; a.ph_hi = p + 1; for (int r = 0; r < ((PROBE_REPEAT >> (p)) & 1 ? 5 : 1); ++r) hipLaunchKernelGGL(hybrid_fwd, dim3(grid), dim3(NWAVES * 64), LDS_BYTES, stream, a); }
#endif
}
```
